# Optimizing an MI355X kernel written in HIP

```python
import math
import jax
import jax.numpy as jnp
from jax import lax
import numpy as np

D_MODEL = 1024
BATCH = 16
SEQ = 2048
DEPTH = 4
DEC_BATCH = 2
DEC_SEQ = 8192
PAST_LEN = 128

ATTN_HEADS = 8
ATTN_KV_HEADS = 2
HEAD_DIM = 64
ATTN_Q_WIDTH = ATTN_HEADS * HEAD_DIM
ATTN_KV_WIDTH = ATTN_KV_HEADS * HEAD_DIM
WINDOW = 128
ATTN_BLOCK = 128
NUM_BUCKETS = 32
MAX_DISTANCE = 128

GMLP_WIDTH = 512
GMLP_GROUPS = 4
GMLP_CHUNK = 128

SSD_INNER = 1024
SSD_HEAD_DIM = 64
SSD_HEADS = SSD_INNER // SSD_HEAD_DIM
SSD_GROUPS = 2
SSD_STATE = 128
SSD_CONV = 3
SSD_CHUNK = 128
SSD_XBC = SSD_INNER + 2 * SSD_GROUPS * SSD_STATE
N_DIR = 2

N_BRANCH = 3
FF_DIM = 4 * D_MODEL
EPS = 1e-6
NEG_INF = -1e30

IN_WIDTHS = (ATTN_Q_WIDTH, ATTN_KV_WIDTH, ATTN_KV_WIDTH, GMLP_WIDTH, GMLP_WIDTH,
             SSD_INNER, SSD_XBC, N_DIR * SSD_HEADS, N_BRANCH * D_MODEL)
IN_PROJ = sum(IN_WIDTHS)

kernel_name = 'hybrid_bidir_encoder'


def _split_points(widths):
    pts, acc = [], 0
    for w in widths[:-1]:
        acc += w
        pts.append(acc)
    return pts


def rms_f32(x, g):
    xf = x.astype(jnp.float32)
    return xf * lax.rsqrt(jnp.mean(xf * xf, axis=-1, keepdims=True) + EPS) * g.astype(jnp.float32)


def rms_norm(x, g):
    return rms_f32(x, g).astype(x.dtype)


def t5_bucket(rel):
    nb = NUM_BUCKETS // 2
    max_exact = nb // 2
    ret = jnp.where(rel > 0, nb, 0)
    n = jnp.abs(rel)
    n_safe = jnp.maximum(n, 1).astype(jnp.float32)
    large = max_exact + (jnp.log(n_safe / max_exact) / math.log(MAX_DISTANCE / max_exact)
                         * (nb - max_exact)).astype(jnp.int32)
    large = jnp.minimum(large, nb - 1)
    return ret + jnp.where(n < max_exact, n, large)


def window_attention(q, k, v, q_g, k_g, sink, rel_bias):
    b, s, _ = q.shape
    nb = s // ATTN_BLOCK
    grp = ATTN_HEADS // ATTN_KV_HEADS
    blk = ATTN_BLOCK
    qn = rms_f32(q.reshape(b, s, ATTN_HEADS, HEAD_DIM), q_g) * (HEAD_DIM ** -0.5)
    qn = qn.reshape(b, nb, blk, ATTN_KV_HEADS, grp, HEAD_DIM)
    kn = rms_f32(k.reshape(b, s, ATTN_KV_HEADS, HEAD_DIM), k_g)
    vv = v.reshape(b, s, ATTN_KV_HEADS, HEAD_DIM).astype(jnp.float32)

    def windows(t):
        tp = jnp.pad(t, ((0, 0), (blk, blk), (0, 0), (0, 0)))
        tb = tp.reshape(b, nb + 2, blk, ATTN_KV_HEADS, HEAD_DIM)
        return jnp.concatenate([tb[:, :-2], tb[:, 1:-1], tb[:, 2:]], axis=2)

    kw = windows(kn)
    vw = windows(vv)
    scores = jnp.einsum('bnqhgd,bnkhd->bnhgqk', qn, kw)
    qi = jnp.arange(blk)[:, None]
    ki = jnp.arange(3 * blk)[None, :]
    rel = ki - blk - qi
    bias = rel_bias[t5_bucket(rel)].astype(jnp.float32)
    bias = bias.transpose(2, 0, 1).reshape(ATTN_KV_HEADS, grp, blk, 3 * blk)
    key_pos = jnp.arange(nb)[:, None] * blk - blk + ki
    mask = (jnp.abs(rel) <= WINDOW)[None] & ((key_pos >= 0) & (key_pos < s))[:, None, :]
    scores = jnp.where(mask[None, :, None, None], scores + bias, NEG_INF)
    snk = sink.astype(jnp.float32).reshape(ATTN_KV_HEADS, grp)[None, None, :, :, None, None]
    m = jnp.maximum(jnp.max(scores, axis=-1, keepdims=True), snk)
    pr = jnp.exp(scores - m)
    denom = jnp.sum(pr, axis=-1, keepdims=True) + jnp.exp(snk - m)
    out = jnp.einsum('bnhgqk,bnkhd->bnqhgd', pr / denom, vw)
    return out.reshape(b, s, ATTN_Q_WIDTH)


def spatial_gating(u, v, ln_g, ln_b, w_s, b_s):
    b, s, _ = u.shape
    u = jax.nn.gelu(u)
    vf = jax.nn.gelu(v).astype(jnp.float32)
    mu = jnp.mean(vf, axis=-1, keepdims=True)
    var = jnp.mean(jnp.square(vf - mu), axis=-1, keepdims=True)
    vn = ((vf - mu) * lax.rsqrt(var + EPS) * ln_g.astype(jnp.float32) + ln_b.astype(jnp.float32)).astype(u.dtype)
    vn = vn.reshape(b, s // GMLP_CHUNK, GMLP_CHUNK, GMLP_GROUPS, GMLP_WIDTH // GMLP_GROUPS)
    sv = jnp.einsum('gts,bcsge->bctge', w_s, vn) + b_s.T[:, :, None]
    return u * sv.reshape(b, s, GMLP_WIDTH)


def ssd_chunked(x, dt, a, bm, cm):
    b, s, h, p = x.shape
    g = bm.shape[2]
    j = h // g
    nc = s // SSD_CHUNK
    L = SSD_CHUNK
    xdt = (x.astype(jnp.float32) * dt[..., None]).reshape(b, nc, L, g, j, p)
    acum = jnp.cumsum((dt * a).reshape(b, nc, L, g, j), axis=2)
    bc = bm.reshape(b, nc, L, g, SSD_STATE)
    cc = cm.reshape(b, nc, L, g, SSD_STATE)
    seg = acum[:, :, :, None] - acum[:, :, None, :]
    tri = jnp.tril(jnp.ones((L, L), dtype=bool))
    decay = jnp.exp(jnp.where(tri[:, :, None, None], seg, -jnp.inf))
    cb = jnp.einsum('bclgn,bcsgn->bclsg', cc, bc)
    y_diag = jnp.einsum('bclsg,bclsgj,bcsgjp->bclgjp', cb, decay, xdt)
    decay_to_end = jnp.exp(acum[:, :, -1:] - acum)
    states = jnp.einsum('bclgn,bclgj,bclgjp->bcgjpn', bc, decay_to_end, xdt)
    chunk_decay = jnp.exp(acum[:, :, -1])

    def step(carry, inp):
        st, dec = inp
        return carry * dec[..., None, None] + st, carry

    init = jnp.zeros((b, g, j, p, SSD_STATE), dtype=states.dtype)
    _, prev = lax.scan(step, init, (jnp.swapaxes(states, 0, 1), jnp.swapaxes(chunk_decay, 0, 1)))
    prev = jnp.swapaxes(prev, 0, 1)
    y_off = jnp.einsum('bclgn,bcgjpn,bclgj->bclgjp', cc, prev, jnp.exp(acum))
    return (y_diag + y_off).reshape(b, s, h, p)


def ssd_branch(z, xbc, dt_raw, conv_w, conv_b, dt_bias, a_log, d_skip, norm_g):
    b, s, _ = xbc.shape
    pad = SSD_CONV // 2
    xp = jnp.pad(xbc, ((0, 0), (pad, pad), (0, 0)))
    conv = conv_b + xp[:, 0:s] * conv_w[0]
    for i in range(1, SSD_CONV):
        conv = conv + xp[:, i:i + s] * conv_w[i]
    xbc = jax.nn.silu(conv)
    xs, bm, cm = jnp.split(xbc, [SSD_INNER, SSD_INNER + SSD_GROUPS * SSD_STATE], axis=-1)
    xs = xs.reshape(b, s, SSD_HEADS, SSD_HEAD_DIM)
    bm = bm.reshape(b, s, SSD_GROUPS, SSD_STATE)
    cm = cm.reshape(b, s, SSD_GROUPS, SSD_STATE)
    dt = jax.nn.softplus(dt_raw.astype(jnp.float32).reshape(b, s, N_DIR, SSD_HEADS) + dt_bias.astype(jnp.float32))
    a = -jnp.exp(a_log.astype(jnp.float32))
    y_fwd = ssd_chunked(xs, dt[:, :, 0], a[0], bm, cm)
    flip = lambda t: jnp.flip(t, axis=1)
    y_bwd = flip(ssd_chunked(flip(xs), flip(dt[:, :, 1]), a[1], flip(bm), flip(cm)))
    y = y_fwd + y_bwd + d_skip.astype(jnp.float32)[:, None] * xs.astype(jnp.float32)
    y = y.reshape(b, s, SSD_INNER) * jax.nn.silu(z.astype(jnp.float32))
    yn = rms_f32(y.reshape(b, s, SSD_GROUPS, SSD_INNER // SSD_GROUPS), norm_g.reshape(SSD_GROUPS, -1))
    return yn.reshape(b, s, SSD_INNER).astype(z.dtype)


def encoder_layer(x, rel_bias, p):
    b, s, _ = x.shape
    xn = rms_norm(x, p['norm_mix_g'])
    proj = xn @ p['w_in']
    q, k, v, gu, gv, z, xbc, dt_raw, gates = jnp.split(proj, _split_points(IN_WIDTHS), axis=-1)
    y_a = window_attention(q, k, v, p['q_norm_g'], p['k_norm_g'], p['attn_sink'], rel_bias).astype(x.dtype)
    y_b = spatial_gating(gu, gv, p['gmlp_ln_g'], p['gmlp_ln_b'], p['w_spatial'], p['b_spatial'])
    y_c = ssd_branch(z, xbc, dt_raw, p['conv_w'], p['conv_b'], p['dt_bias'], p['a_log'], p['d_skip'], p['ssd_norm_g'])
    gt = jax.nn.sigmoid(gates.astype(jnp.float32)).astype(x.dtype).reshape(b, s, N_BRANCH, D_MODEL)
    merged = (gt[:, :, 0] * (y_a @ p['w_up_attn'])
              + gt[:, :, 1] * (y_b @ p['w_up_gmlp'])
              + gt[:, :, 2] * (y_c @ p['w_up_ssd']))
    h = x + merged @ p['w_out']
    hn = rms_norm(h, p['norm_ff_g'])
    ff = jnp.square(jax.nn.relu(hn @ p['w_ff1'])) @ p['w_ff2']
    return h + ff


def setup_inputs(seed: int = 0) -> dict:
    key = jax.random.key(seed)
    ks = jax.random.split(key, 32)
    f32 = jnp.float32

    def nrm(k, shape, scale):
        return jax.random.normal(k, shape, f32) * scale

    def gain(k, shape):
        return 1.0 + 0.05 * jax.random.normal(k, shape, f32)

    dt0 = jnp.exp(jax.random.uniform(ks[15], (DEPTH, N_DIR, SSD_HEADS), f32, math.log(1e-3), math.log(1e-1)))
    return {
        'x_prompt': nrm(ks[0], (BATCH, SEQ, D_MODEL), 1.0),
        'x_sample': nrm(ks[1], (DEC_BATCH, DEC_SEQ, D_MODEL), 1.0),
        'rel_bias': nrm(ks[2], (NUM_BUCKETS, ATTN_HEADS), 0.5),
        'norm_mix_g': gain(ks[3], (DEPTH, D_MODEL)),
        'w_in': nrm(ks[4], (DEPTH, D_MODEL, IN_PROJ), D_MODEL ** -0.5),
        'q_norm_g': gain(ks[5], (DEPTH, HEAD_DIM)),
        'k_norm_g': gain(ks[6], (DEPTH, HEAD_DIM)),
        'attn_sink': nrm(ks[7], (DEPTH, ATTN_HEADS), 1.0),
        'gmlp_ln_g': gain(ks[8], (DEPTH, GMLP_WIDTH)),
        'gmlp_ln_b': nrm(ks[9], (DEPTH, GMLP_WIDTH), 0.02),
        'w_spatial': nrm(ks[10], (DEPTH, GMLP_GROUPS, GMLP_CHUNK, GMLP_CHUNK), GMLP_CHUNK ** -0.5),
        'b_spatial': gain(ks[11], (DEPTH, GMLP_GROUPS, GMLP_CHUNK)),
        'conv_w': nrm(ks[12], (DEPTH, SSD_CONV, SSD_XBC), SSD_CONV ** -0.5),
        'conv_b': nrm(ks[13], (DEPTH, SSD_XBC), 0.02),
        'dt_bias': dt0 + jnp.log(-jnp.expm1(-dt0)),
        'a_log': jnp.log(jax.random.uniform(ks[14], (DEPTH, N_DIR, SSD_HEADS), f32, 1.0, 16.0)),
        'd_skip': gain(ks[16], (DEPTH, SSD_HEADS)),
        'ssd_norm_g': gain(ks[17], (DEPTH, SSD_INNER)),
        'w_up_attn': nrm(ks[18], (DEPTH, ATTN_Q_WIDTH, D_MODEL), ATTN_Q_WIDTH ** -0.5),
        'w_up_gmlp': nrm(ks[19], (DEPTH, GMLP_WIDTH, D_MODEL), GMLP_WIDTH ** -0.5),
        'w_up_ssd': nrm(ks[20], (DEPTH, SSD_INNER, D_MODEL), SSD_INNER ** -0.5),
        'w_out': nrm(ks[21], (DEPTH, D_MODEL, D_MODEL), D_MODEL ** -0.5),
        'norm_ff_g': gain(ks[22], (DEPTH, D_MODEL)),
        'w_ff1': nrm(ks[23], (DEPTH, D_MODEL, FF_DIM), D_MODEL ** -0.5),
        'w_ff2': nrm(ks[24], (DEPTH, FF_DIM, D_MODEL), FF_DIM ** -0.5),
    }


def reference(x_prompt, x_sample, rel_bias, norm_mix_g, w_in, q_norm_g, k_norm_g, attn_sink,
              gmlp_ln_g, gmlp_ln_b, w_spatial, b_spatial, conv_w, conv_b, dt_bias, a_log, d_skip,
              ssd_norm_g, w_up_attn, w_up_gmlp, w_up_ssd, w_out, norm_ff_g, w_ff1, w_ff2):
    y_prompt = x_prompt
    y_sample = x_sample
    for l in range(DEPTH):
        p = {
            'norm_mix_g': norm_mix_g[l], 'w_in': w_in[l],
            'q_norm_g': q_norm_g[l], 'k_norm_g': k_norm_g[l], 'attn_sink': attn_sink[l],
            'gmlp_ln_g': gmlp_ln_g[l], 'gmlp_ln_b': gmlp_ln_b[l],
            'w_spatial': w_spatial[l], 'b_spatial': b_spatial[l],
            'conv_w': conv_w[l], 'conv_b': conv_b[l], 'dt_bias': dt_bias[l], 'a_log': a_log[l],
            'd_skip': d_skip[l], 'ssd_norm_g': ssd_norm_g[l],
            'w_up_attn': w_up_attn[l], 'w_up_gmlp': w_up_gmlp[l], 'w_up_ssd': w_up_ssd[l],
            'w_out': w_out[l], 'norm_ff_g': norm_ff_g[l], 'w_ff1': w_ff1[l], 'w_ff2': w_ff2[l],
        }
        y_prompt = encoder_layer(y_prompt, rel_bias, p)
        y_sample = encoder_layer(y_sample, rel_bias, p)
    return (y_prompt, y_sample)
```

```cpp
#include <hip/hip_runtime.h>
#include <hip/hip_fp16.h>
#include <hip/hip_cooperative_groups.h>
namespace cg = cooperative_groups;

#ifndef MULTI_LAUNCH
#define MULTI_LAUNCH 1
#endif

typedef _Float16 h16;
using h16x8 = __attribute__((ext_vector_type(8))) _Float16;
using h16x4 = __attribute__((ext_vector_type(4))) _Float16;
using h16x2 = __attribute__((ext_vector_type(2))) _Float16;
using f32x4 = __attribute__((ext_vector_type(4))) float;

constexpr int LDP = 7456, TG = 16384, NLAYER = 4;
constexpr int CQ = 0, CK = 512, CV = 640, CGU = 768, CGV = 1280, CZ = 1792, CX = 2816, CDT = 4352, CG = 4384;
constexpr float EPS = 1e-6f;
constexpr long O_WIN = 0, O_UPA = 7456L * 1024, O_UPB = O_UPA + 524288, O_UPC = O_UPB + 524288, O_WOUT = O_UPC + 1048576,
               O_FF1 = O_WOUT + 1048576, O_FF2 = O_FF1 + 4194304, O_WSP = O_FF2 + 4194304, WL = O_WSP + 65536;
constexpr int SHM_GEMM = 131072, SHM_TOTAL = SHM_GEMM + 2048;
constexpr int NSTEPS = 1 + 3 * 33;

#define PFIELDS(X)                                                                                                         \
  X(0, const float*, x_prompt) X(1, const float*, x_sample) X(2, const float*, rel_bias) X(3, const float*, norm_mix_g)    \
  X(4, const float*, w_in) X(5, const float*, q_norm_g) X(6, const float*, k_norm_g) X(7, const float*, attn_sink)         \
  X(8, const float*, gmlp_ln_g) X(9, const float*, gmlp_ln_b) X(10, const float*, w_spatial) X(11, const float*, b_spatial) \
  X(12, const float*, conv_w) X(13, const float*, conv_b) X(14, const float*, dt_bias) X(15, const float*, a_log)          \
  X(16, const float*, d_skip) X(17, const float*, ssd_norm_g) X(18, const float*, w_up_attn) X(19, const float*, w_up_gmlp) \
  X(20, const float*, w_up_ssd) X(21, const float*, w_out) X(22, const float*, norm_ff_g) X(23, const float*, w_ff1)       \
  X(24, const float*, w_ff2) X(25, float*, out) X(26, h16*, wt) X(27, h16*, proj) X(28, h16*, bufA) X(29, h16*, bufB)      \
  X(30, h16*, xc) X(31, float*, rssX) X(32, float*, rssH) X(33, float*, dtbuf)
struct Params {
#define X(i, T, n) T n;
  PFIELDS(X)
#undef X
  int step_lo, step_hi;
};

__device__ __forceinline__ float wave_sum(float v) {
#pragma unroll
  for (int o = 32; o > 0; o >>= 1) v += __shfl_xor(v, o, 64);
  return v;
}
__device__ __forceinline__ float gelu_t(float x) {
  float u = 0.7978845608028654f * (x + 0.044715f * x * x * x);
  return 0.5f * x * (1.f + tanhf(u));
}
__device__ __forceinline__ float silu_f(float x) { return x / (1.f + __expf(-x)); }
__device__ __forceinline__ float clampf(float x, float lo, float hi) { return fminf(fmaxf(x, lo), hi); }

__device__ __forceinline__ int opaque_tid() { int t = threadIdx.x; asm volatile("" : "+v"(t)); return t; }
__device__ __forceinline__ int opaque_bid() { int b = blockIdx.x; asm volatile("" : "+s"(b)); return b; }
#define CTX const int TIDX = opaque_tid(); const int BIDX = opaque_bid(); (void)TIDX; (void)BIDX

__device__ void prep_tile(const float* __restrict__ src, int K, int N, h16* __restrict__ dst, const float* __restrict__ scale,
                          int nt, int kt, char* shm) {
  CTX;
  float(*tile)[65] = (float(*)[65])shm;
  const int tid = TIDX;
  const int n0 = nt * 64, k0 = kt * 64;
  {
    int nn = tid & 63, kk0 = tid >> 6;
#pragma unroll
    for (int i = 0; i < 8; ++i) {
      int kk = kk0 + 8 * i;
      float v = 0.f;
      if (n0 + nn < N) {
        v = src[(size_t)(k0 + kk) * N + n0 + nn];
        if (scale) v *= scale[k0 + kk];
      }
      tile[kk][nn] = v;
    }
  }
  __syncthreads();
  {
    int kk = tid & 63, nn0 = tid >> 6;
#pragma unroll
    for (int i = 0; i < 8; ++i) {
      int nn = nn0 + 8 * i;
      if (n0 + nn < N) dst[(size_t)(n0 + nn) * K + k0 + kk] = (h16)tile[kk][nn];
    }
  }
  __syncthreads();
}

__device__ void phase_prep(const Params& p, char* shm) {
  CTX;
  constexpr int T_IN = 117 * 16, T_UA = 16 * 8, T_UC = 16 * 16, T_F = 64 * 16, T_SP = 16;
  constexpr int PER = T_IN + 2 * T_UA + 2 * T_UC + 2 * T_F + T_SP;
  for (int item = BIDX; item < PER * NLAYER; item += gridDim.x) {
    int l = item / PER, r = item % PER;
    h16* wl = p.wt + (size_t)l * WL;
    if (r < T_IN) { prep_tile(p.w_in + (size_t)l * 1024 * LDP, 1024, LDP, wl + O_WIN, p.norm_mix_g + l * 1024, r / 16, r % 16, shm); continue; }
    r -= T_IN;
    if (r < T_UA) { prep_tile(p.w_up_attn + (size_t)l * 512 * 1024, 512, 1024, wl + O_UPA, nullptr, r / 8, r % 8, shm); continue; }
    r -= T_UA;
    if (r < T_UA) { prep_tile(p.w_up_gmlp + (size_t)l * 512 * 1024, 512, 1024, wl + O_UPB, nullptr, r / 8, r % 8, shm); continue; }
    r -= T_UA;
    if (r < T_UC) { int hf = r >> 7, rr = r & 127; prep_tile(p.w_up_ssd + (size_t)l * 1024 * 1024 + (size_t)hf * 512 * 1024, 512, 1024, wl + O_UPC + hf * 524288, nullptr, rr / 8, rr % 8, shm); continue; }
    r -= T_UC;
    if (r < T_UC) { prep_tile(p.w_out + (size_t)l * 1024 * 1024, 1024, 1024, wl + O_WOUT, nullptr, r / 16, r % 16, shm); continue; }
    r -= T_UC;
    if (r < T_F) { prep_tile(p.w_ff1 + (size_t)l * 1024 * 4096, 1024, 4096, wl + O_FF1, p.norm_ff_g + l * 1024, r / 16, r % 16, shm); continue; }
    r -= T_F;
    if (r < T_F) { prep_tile(p.w_ff2 + (size_t)l * 4096 * 1024, 4096, 1024, wl + O_FF2, nullptr, r / 64, r % 64, shm); continue; }
    r -= T_F;
    {
      const float* s = p.w_spatial + (size_t)l * 65536 + r * 4096;
      h16* d = wl + O_WSP + r * 4096;
      for (int i = TIDX; i < 4096; i += 512) d[i] = (h16)s[i];
    }
  }
}

__device__ void phase_pre(const Params& p, int g) {
  CTX;
  const float* xin = (g < 2) ? p.x_prompt + (size_t)g * TG * 1024 : p.x_sample;
  float* xo = p.out + (size_t)g * TG * 1024;
  const int wid = TIDX >> 6, lane = TIDX & 63;
  for (int row = BIDX * 8 + wid; row < TG; row += gridDim.x * 8) {
    const float4* s4 = (const float4*)(xin + (size_t)row * 1024);
    float4* d4 = (float4*)(xo + (size_t)row * 1024);
    float ss = 0.f;
#pragma unroll
    for (int i = 0; i < 4; ++i) {
      int idx = i * 64 + lane;
      float4 v = s4[idx];
      d4[idx] = v;
      ss += v.x * v.x + v.y * v.y + v.z * v.z + v.w * v.w;
      h16x4 hv = {(h16)v.x, (h16)v.y, (h16)v.z, (h16)v.w};
      *(h16x4*)(p.bufA + (size_t)row * 1024 + idx * 4) = hv;
    }
    ss = wave_sum(ss);
    if (lane == 0) p.rssX[row] = ss;
  }
}

#define LAS __attribute__((address_space(3)))
constexpr int BK = 64, HALF = 128, HTB = HALF * BK * 2;
__device__ __forceinline__ int lds_byte(int r, int c) {
  const int st = (r >> 4) * 2 + (c >> 5), rr = r & 15, cc = c & 31, ob = rr * 64 + cc * 2;
  return st * 1024 + (ob ^ (((ob >> 9) & 1) << 5));
}
__device__ __forceinline__ void stage_rc(int b, int& R, int& C) {
  const int st = b / 1024, sb = b % 1024, swz = sb ^ (((sb >> 9) & 1) << 5);
  R = (st >> 1) * 16 + swz / 64;
  C = (st & 1) * 32 + (swz % 64) / 2;
}
__device__ __forceinline__ int perm32(int rho) { const int n = rho >> 4, i = rho & 15; return 8 * (i >> 2) + 4 * n + (i & 3); }

struct Unit { const char* A; const char* B; int pm, pn, seg; };

__device__ __forceinline__ void tile_map(int t, int total, int nN, int& pm, int& pn) {
  int base = t & ~255, i = t & 255;
  int R = min(256, total - base);
  int id = (R & 7) ? t : base + (i & 7) * (R >> 3) + (i >> 3);
  int band = id / (8 * nN), w = id % (8 * nN);
  pm = band * 8 + (w & 7);
  pn = w >> 3;
}

template <class Sched, class Epi>
__device__ __forceinline__ void gemm_phase(LAS unsigned char* lds, const int lda, const int ldb, const int nt, const Sched& S, const Epi& E) {
  CTX;
  const int tid = TIDX, wid = __builtin_amdgcn_readfirstlane(tid >> 6), lane = tid & 63, wr = wid >> 2, wc = wid & 3, fr = lane & 15, fq = lane >> 4;
  unsigned voffA[2], voffB[2];
#pragma unroll
  for (int i = 0; i < 2; ++i) {
    int R, C;
    stage_rc(tid * 16 + i * 8192, R, C);
    const int Rb = (R & ~31) + perm32(R & 31);
    voffA[i] = (unsigned)(R * lda + C) * 2u;
    voffB[i] = (unsigned)(Rb * ldb + C) * 2u;
  }
  const size_t kstep = (size_t)(BK * 2);
  const size_t hstepA = (size_t)HALF * lda * 2, hstepB = (size_t)HALF * ldb * 2;
  const unsigned ldsw = (unsigned)wid * 1024u;
  const int aoff = lds_byte(wr * 64 + fr, fq * 8), boff = lds_byte(wc * 32 + fr, fq * 8);
#define G_SA(b, h) (((b)*2 + (h)) * HTB)
#define G_SB(b, h) ((4 + (b)*2 + (h)) * HTB)
#define G_STAGE(bufoff, gbase, voff)                                                                                        \
  do {                                                                                                                      \
    _Pragma("unroll") for (int _i = 0; _i < 2; ++_i) __builtin_amdgcn_global_load_lds(                                      \
        (const unsigned*)((const char*)(gbase) + (voff)[_i]), (LAS unsigned*)(lds + (bufoff) + ldsw + _i * 8192), 16, 0, 0); \
  } while (0)
#define G_LDA(dst, b, h)                                                                                                    \
  do {                                                                                                                      \
    _Pragma("unroll") for (int m = 0; m < 4; ++m) _Pragma("unroll") for (int k = 0; k < 2; ++k) dst[m][k] =                 \
        *(const LAS h16x8*)(lds + G_SA(b, h) + aoff + m * 2048 + k * 1024);                                                 \
  } while (0)
#define G_LDB(dst, b, h)                                                                                                    \
  do {                                                                                                                      \
    _Pragma("unroll") for (int n = 0; n < 2; ++n) _Pragma("unroll") for (int k = 0; k < 2; ++k) dst[n][k] =                 \
        *(const LAS h16x8*)(lds + G_SB(b, h) + boff + n * 2048 + k * 1024);                                                 \
  } while (0)
#define G_MMA(ai, bj, At_, Bt_)                                                                                             \
  do {                                                                                                                      \
    __builtin_amdgcn_s_setprio(1);                                                                                          \
    _Pragma("unroll") for (int m = 0; m < 4; ++m) _Pragma("unroll") for (int n = 0; n < 2; ++n)                             \
    _Pragma("unroll") for (int k = 0; k < 2; ++k) acc[ai][bj][m][n] =                                                       \
        __builtin_amdgcn_mfma_f32_16x16x32_f16(Bt_[n][k], At_[m][k], acc[ai][bj][m][n], 0, 0, 0);                           \
    __builtin_amdgcn_s_setprio(0);                                                                                          \
  } while (0)
#define G_WAIT_V(n) asm volatile("s_waitcnt vmcnt(" #n ")" ::: "memory")
#define G_WAIT_L(n) asm volatile("s_waitcnt lgkmcnt(" #n ")" ::: "memory")
#define G_BAR __builtin_amdgcn_s_barrier()
#define G_SCHED __builtin_amdgcn_sched_barrier(0)
#define G_ZERO                                                                                       \
  _Pragma("unroll") for (int a = 0; a < 2; ++a) _Pragma("unroll") for (int b = 0; b < 2; ++b)        \
  _Pragma("unroll") for (int m = 0; m < 4; ++m) _Pragma("unroll") for (int n = 0; n < 2; ++n) acc[a][b][m][n] = f32x4{0.f, 0.f, 0.f, 0.f}
  Unit cur, nxt;
  int ui = 0;
  if (!S.next(0, cur)) return;
  f32x4 acc[2][2][4][2];
  G_ZERO;
  h16x8 At[4][2], B0[2][2], B1[2][2];
  const char* cA = cur.A;
  const char* cB = cur.B;
  G_STAGE(G_SB(0, 0), cB, voffB); G_STAGE(G_SA(0, 0), cA, voffA); G_STAGE(G_SB(0, 1), cB + hstepB, voffB); G_STAGE(G_SA(0, 1), cA + hstepA, voffA);
  if (wr == 1) G_BAR;
  G_WAIT_V(4); G_BAR;
  G_STAGE(G_SB(1, 0), cB + kstep, voffB); G_STAGE(G_SA(1, 0), cA + kstep, voffA); G_STAGE(G_SB(1, 1), cB + hstepB + kstep, voffB);
  G_WAIT_V(6); G_BAR;
  for (;;) {
    const bool has_next = S.next(ui + 1, nxt);
    const char* nA = has_next ? nxt.A : cA;
    const char* nB = has_next ? nxt.B : cB;
    for (int t = 0; t < nt; t += 2) {
      const bool last = (t == nt - 2);
      const char* a1 = cA + (size_t)(t + 1) * kstep;
      const char* a2 = last ? nA : cA + (size_t)(t + 2) * kstep;
      const char* b2 = last ? nB : cB + (size_t)(t + 2) * kstep;
      const char* a3 = a2 + kstep;
      const char* b3 = b2 + kstep;
      G_LDB(B0, 0, 0); G_SCHED; G_LDA(At, 0, 0); G_STAGE(G_SA(1, 1), a1 + hstepA, voffA);
      G_WAIT_L(8); G_BAR; G_WAIT_L(0); G_MMA(0, 0, At, B0); G_BAR; G_SCHED;
      G_LDB(B1, 0, 1); G_STAGE(G_SB(0, 0), b2, voffB);
      G_BAR; G_WAIT_L(0); G_MMA(0, 1, At, B1); G_BAR;
      G_LDA(At, 0, 1); G_STAGE(G_SA(0, 0), a2, voffA);
      G_BAR; G_WAIT_L(0); G_MMA(1, 0, At, B0); G_BAR; G_SCHED;
      G_STAGE(G_SB(0, 1), b2 + hstepB, voffB);
      G_WAIT_V(6); G_BAR; G_MMA(1, 1, At, B1); G_BAR;
      G_LDB(B0, 1, 0); G_SCHED; G_LDA(At, 1, 0); G_STAGE(G_SA(0, 1), a2 + hstepA, voffA);
      G_WAIT_L(8); G_BAR; G_WAIT_L(0); G_MMA(0, 0, At, B0); G_BAR; G_SCHED;
      G_LDB(B1, 1, 1); G_STAGE(G_SB(1, 0), b3, voffB);
      G_BAR; G_WAIT_L(0); G_MMA(0, 1, At, B1); G_BAR;
      G_LDA(At, 1, 1); G_STAGE(G_SA(1, 0), a3, voffA);
      G_BAR; G_WAIT_L(0); G_MMA(1, 0, At, B0); G_BAR; G_SCHED;
      G_STAGE(G_SB(1, 1), b3 + hstepB, voffB);
      G_WAIT_V(6); G_BAR; G_MMA(1, 1, At, B1); G_BAR;
    }
    const bool clr = E(acc, cur, wr, wc, fr, fq);
    if (!has_next) break;
    if (clr) { G_ZERO; }
    cur = nxt; cA = nA; cB = nB; ++ui;
  }
  G_WAIT_V(0);
  if (wr == 0) G_BAR;
  G_BAR;
}

struct SchedTiles {
  const char *A, *B; size_t tstepA, tstepB; int nN, total, G, c;
  __device__ __forceinline__ bool next(int i, Unit& u) const {
    const long L = (long)i * G + c;
    if (L >= total) return false;
    tile_map((int)L, total, nN, u.pm, u.pn);
    u.A = A + (size_t)u.pm * tstepA; u.B = B + (size_t)u.pn * tstepB; u.seg = 0;
    return true;
  }
};
struct SchedMerge {
  const char *proj, *wl; int G, c;
  __device__ __forceinline__ bool next(int i, Unit& u) const {
    const int tile = (i >> 2) * G + c;
    if (tile >= 256) return false;
    const int seg = i & 3;
    tile_map(tile, 256, 4, u.pm, u.pn);
    const int acol = seg == 0 ? CQ : seg == 1 ? CGU : seg == 2 ? CZ : CZ + 512;
    const long bo = seg == 0 ? O_UPA : seg == 1 ? O_UPB : seg == 2 ? O_UPC : O_UPC + 524288;
    u.A = proj + ((size_t)u.pm * 256 * LDP + acol) * 2;
    u.B = wl + ((size_t)bo + (size_t)u.pn * 256 * 512) * 2;
    u.seg = seg;
    return true;
  }
};

#define FOR_ROWS _Pragma("unroll") for (int ai = 0; ai < 2; ++ai) _Pragma("unroll") for (int m = 0; m < 4; ++m)
__device__ __forceinline__ h16x8 pack8(f32x4 a, f32x4 b) {
  h16x8 r = {(h16)a[0], (h16)a[1], (h16)a[2], (h16)a[3], (h16)b[0], (h16)b[1], (h16)b[2], (h16)b[3]};
  return r;
}

struct EpiInproj {
  h16* proj; float* dtbuf; const float* rss;
  __device__ __forceinline__ bool operator()(f32x4 (&acc)[2][2][4][2], const Unit& u, int wr, int wc, int fr, int fq) const {
    const int row0 = u.pm * 256 + wr * 64 + fr, col0 = u.pn * 256 + wc * 32 + 8 * fq;
    FOR_ROWS {
      const size_t row = row0 + ai * 128 + m * 16;
      const float rs = rsqrtf(rss[row] * (1.f / 1024.f) + EPS);
      h16* rp = proj + row * LDP + col0;
#pragma unroll
      for (int bj = 0; bj < 2; ++bj) {
        const int col = col0 + bj * 128;
        if (col < LDP) {
          f32x4 v0 = acc[ai][bj][m][0] * rs, v1 = acc[ai][bj][m][1] * rs;
          *(h16x8*)(rp + bj * 128) = pack8(v0, v1);
          if (col >= CDT && col < CDT + 32) {
            *(f32x4*)(dtbuf + row * 32 + (col - CDT)) = v0;
            *(f32x4*)(dtbuf + row * 32 + (col - CDT) + 4) = v1;
          }
        }
      }
    }
    return true;
  }
};

__device__ __forceinline__ float sig_ratio(float a, float b) {
  a = clampf(a, -30.f, 30.f);
  b = clampf(b, -30.f, 30.f);
  return (1.f + __expf(-b)) / (1.f + __expf(-a));
}
struct EpiMerge {
  const h16* proj; h16* dst;
  __device__ __forceinline__ bool operator()(f32x4 (&acc)[2][2][4][2], const Unit& u, int wr, int wc, int fr, int fq) const {
    if (u.seg == 2) return false;
    const int row0 = u.pm * 256 + wr * 64 + fr, col0 = u.pn * 256 + wc * 32 + 8 * fq;
    FOR_ROWS {
      const size_t row = row0 + ai * 128 + m * 16;
      const h16* gp = proj + row * LDP + CG + col0;
#pragma unroll
      for (int bj = 0; bj < 2; ++bj) {
        if (u.seg < 2) {
          h16x8 ga = *(const h16x8*)(gp + u.seg * 1024 + bj * 128), gb = *(const h16x8*)(gp + (u.seg + 1) * 1024 + bj * 128);
#pragma unroll
          for (int j = 0; j < 4; ++j) {
            acc[ai][bj][m][0][j] *= sig_ratio((float)ga[j], (float)gb[j]);
            acc[ai][bj][m][1][j] *= sig_ratio((float)ga[4 + j], (float)gb[4 + j]);
          }
        } else {
          h16x8 gc = *(const h16x8*)(gp + 2048 + bj * 128);
          f32x4 v0, v1;
#pragma unroll
          for (int j = 0; j < 4; ++j) {
            v0[j] = acc[ai][bj][m][0][j] / (1.f + __expf(-clampf((float)gc[j], -30.f, 30.f)));
            v1[j] = acc[ai][bj][m][1][j] / (1.f + __expf(-clampf((float)gc[4 + j], -30.f, 30.f)));
          }
          *(h16x8*)(dst + row * 1024 + col0 + bj * 128) = pack8(v0, v1);
        }
      }
    }
    return u.seg == 3;
  }
};

struct EpiResid {
  float* xo; h16* copy; float* rss;
  __device__ __forceinline__ bool operator()(f32x4 (&acc)[2][2][4][2], const Unit& u, int wr, int wc, int fr, int fq) const {
    const int row0 = u.pm * 256 + wr * 64 + fr, col0 = u.pn * 256 + wc * 32 + 8 * fq;
    FOR_ROWS {
      const size_t row = row0 + ai * 128 + m * 16;
      float ss = 0.f;
#pragma unroll
      for (int bj = 0; bj < 2; ++bj) {
        float* xp = xo + row * 1024 + col0 + bj * 128;
        f32x4 v0 = *(f32x4*)xp + acc[ai][bj][m][0], v1 = *(f32x4*)(xp + 4) + acc[ai][bj][m][1];
        *(f32x4*)xp = v0;
        *(f32x4*)(xp + 4) = v1;
        *(h16x8*)(copy + row * 1024 + col0 + bj * 128) = pack8(v0, v1);
#pragma unroll
        for (int j = 0; j < 4; ++j) ss += v0[j] * v0[j] + v1[j] * v1[j];
      }
      ss += __shfl_xor(ss, 16, 64);
      ss += __shfl_xor(ss, 32, 64);
      if (fq == 0) atomicAdd(rss + row, ss);
    }
    return true;
  }
};

struct EpiFF1 {
  h16* hid; const float* rss;
  __device__ __forceinline__ bool operator()(f32x4 (&acc)[2][2][4][2], const Unit& u, int wr, int wc, int fr, int fq) const {
    const int row0 = u.pm * 256 + wr * 64 + fr, col0 = u.pn * 256 + wc * 32 + 8 * fq;
    FOR_ROWS {
      const size_t row = row0 + ai * 128 + m * 16;
      const float rs = rsqrtf(rss[row] * (1.f / 1024.f) + EPS);
#pragma unroll
      for (int bj = 0; bj < 2; ++bj) {
        f32x4 v0 = acc[ai][bj][m][0] * rs, v1 = acc[ai][bj][m][1] * rs;
#pragma unroll
        for (int j = 0; j < 4; ++j) {
          float a = fmaxf(v0[j], 0.f), b = fmaxf(v1[j], 0.f);
          v0[j] = a * a; v1[j] = b * b;
        }
        *(h16x8*)(hid + row * 4096 + col0 + bj * 128) = pack8(v0, v1);
      }
    }
    return true;
  }
};

__device__ __forceinline__ void zero_f32(float* p, int n) {
  CTX;
  for (int i = BIDX * 512 + TIDX; i < n; i += gridDim.x * 512) p[i] = 0.f;
}

__device__ void phase_inproj(const Params& p, int l, char* shm) {
  CTX;
  zero_f32(p.rssH, TG);
  SchedTiles S{(const char*)p.bufA, (const char*)(p.wt + (size_t)l * WL + O_WIN), (size_t)256 * 1024 * 2, (size_t)256 * 1024 * 2, 30, 64 * 30, (int)gridDim.x, (int)BIDX};
  EpiInproj E{p.proj, p.dtbuf, p.rssX};
  gemm_phase((LAS unsigned char*)shm, 1024, 1024, 16, S, E);
}
__device__ void phase_merge(const Params& p, int l, char* shm) {
  CTX;
  SchedMerge S{(const char*)p.proj, (const char*)(p.wt + (size_t)l * WL), (int)gridDim.x, (int)BIDX};
  EpiMerge E{p.proj, p.bufA};
  gemm_phase((LAS unsigned char*)shm, LDP, 512, 8, S, E);
}
__device__ void phase_wout(const Params& p, int g, int l, char* shm) {
  CTX;
  SchedTiles S{(const char*)p.bufA, (const char*)(p.wt + (size_t)l * WL + O_WOUT), (size_t)256 * 1024 * 2, (size_t)256 * 1024 * 2, 4, 256, (int)gridDim.x, (int)BIDX};
  EpiResid E{p.out + (size_t)g * TG * 1024, p.bufB, p.rssH};
  gemm_phase((LAS unsigned char*)shm, 1024, 1024, 16, S, E);
}
__device__ void phase_ff1(const Params& p, int l, char* shm) {
  CTX;
  zero_f32(p.rssX, TG);
  SchedTiles S{(const char*)p.bufB, (const char*)(p.wt + (size_t)l * WL + O_FF1), (size_t)256 * 1024 * 2, (size_t)256 * 1024 * 2, 16, 64 * 16, (int)gridDim.x, (int)BIDX};
  EpiFF1 E{p.proj, p.rssH};
  gemm_phase((LAS unsigned char*)shm, 1024, 1024, 16, S, E);
}
__device__ void phase_ff2(const Params& p, int g, int l, char* shm) {
  CTX;
  SchedTiles S{(const char*)p.proj, (const char*)(p.wt + (size_t)l * WL + O_FF2), (size_t)256 * 4096 * 2, (size_t)256 * 4096 * 2, 4, 256, (int)gridDim.x, (int)BIDX};
  EpiResid E{p.out + (size_t)g * TG * 1024, p.bufA, p.rssX};
  gemm_phase((LAS unsigned char*)shm, 4096, 4096, 64, S, E);
}

__device__ void phase_conv(const Params& p, int g, int l) {
  CTX;
  const int S = (g < 2) ? 2048 : 8192;
  const float* cw = p.conv_w + (size_t)l * 3 * 1536;
  const float* cb = p.conv_b + (size_t)l * 1536;
  const int total = TG * 192;
  for (int idx = BIDX * 512 + TIDX; idx < total; idx += gridDim.x * 512) {
    int t = idx / 192, c8 = (idx % 192) * 8;
    int tl = t & (S - 1);
    const h16* base = p.proj + (size_t)t * LDP + CX + c8;
    h16x8 zero = {0, 0, 0, 0, 0, 0, 0, 0};
    h16x8 cur = *(const h16x8*)base;
    h16x8 prv = (tl > 0) ? *(const h16x8*)(base - LDP) : zero;
    h16x8 nxt = (tl < S - 1) ? *(const h16x8*)(base + LDP) : zero;
    h16x8 o;
#pragma unroll
    for (int j = 0; j < 8; ++j) {
      int c = c8 + j;
      float v = cb[c] + (float)prv[j] * cw[c] + (float)cur[j] * cw[1536 + c] + (float)nxt[j] * cw[3072 + c];
      o[j] = (h16)silu_f(v);
    }
    *(h16x8*)(p.xc + (size_t)t * 1536 + c8) = o;
  }
  for (int idx = BIDX * 512 + TIDX; idx < TG * 32; idx += gridDim.x * 512) {
    float v = p.dtbuf[idx] + p.dt_bias[l * 32 + (idx & 31)];
    p.dtbuf[idx] = (v > 20.f) ? v : log1pf(expf(v));
  }
}

__device__ __forceinline__ int t5_bucket(int rel) {
  int ret = rel > 0 ? 16 : 0;
  int n = rel < 0 ? -rel : rel;
  if (n < 8) return ret + n;
  int large = 8;
#pragma unroll
  for (int k = 1; k <= 7; ++k) large += (n * n >= (64 << k)) ? 1 : 0;
  return ret + min(large, 15);
}

__device__ void phase_attn(const Params& p, int g, int l, char* shm) {
  CTX;
  const int S = (g < 2) ? 2048 : 8192;
  h16* Ks = (h16*)shm;
  h16* Vs = Ks + 384 * 66;
  float* bias_s = (float*)(shm + 2 * 384 * 66 * 2);
  const int tid = TIDX;
  const float* kg = p.k_norm_g + l * 64;
  const float* qg = p.q_norm_g + l * 64;
  const int nitems = (TG / 128) * 2;
  for (int item = BIDX; item < nitems; item += gridDim.x) {
    const int hk = item & 1, blk = item >> 1;
    const int t0 = blk * 128, seq = t0 / S, q0 = t0 % S;
    for (int i = tid; i < 4 * 257; i += 512) {
      int gq = i / 257, rel = i % 257 - 128;
      bias_s[i] = p.rel_bias[t5_bucket(rel) * 8 + hk * 4 + gq];
    }
    for (int task = tid; task < 384 * 8; task += 512) {
      int r = task >> 3, c = (task & 7) * 8;
      int kp = q0 - 128 + r;
      bool valid = (kp >= 0) && (kp < S);
      h16x8 kv = {0, 0, 0, 0, 0, 0, 0, 0}, vv = kv;
      if (valid) {
        const h16* rp = p.proj + (size_t)(seq * S + kp) * LDP;
        kv = *(const h16x8*)(rp + CK + hk * 64 + c);
        vv = *(const h16x8*)(rp + CV + hk * 64 + c);
      }
      float kf[8], ss = 0.f;
#pragma unroll
      for (int j = 0; j < 8; ++j) { kf[j] = (float)kv[j]; ss += kf[j] * kf[j]; }
      ss += __shfl_xor(ss, 1, 64);
      ss += __shfl_xor(ss, 2, 64);
      ss += __shfl_xor(ss, 4, 64);
      float rs = rsqrtf(ss * (1.f / 64.f) + EPS);
#pragma unroll
      for (int j = 0; j < 8; j += 2) {
        h16x2 k2 = {(h16)(kf[j] * rs * kg[c + j]), (h16)(kf[j + 1] * rs * kg[c + j + 1])};
        h16x2 v2 = {vv[j], vv[j + 1]};
        *(h16x2*)(Ks + r * 66 + c + j) = k2;
        *(h16x2*)(Vs + r * 66 + c + j) = v2;
      }
    }
    __syncthreads();
    const int gq = tid >> 7, i = tid & 127, hq = hk * 4 + gq;
    h16* qp = p.proj + (size_t)(seq * S + q0 + i) * LDP + CQ + hq * 64;
    float q[64], o[64];
    {
      float ss = 0.f;
#pragma unroll
      for (int c = 0; c < 64; c += 8) {
        h16x8 qv = *(const h16x8*)(qp + c);
#pragma unroll
        for (int j = 0; j < 8; ++j) { q[c + j] = (float)qv[j]; ss += q[c + j] * q[c + j]; }
      }
      float rs = rsqrtf(ss * (1.f / 64.f) + EPS) * 0.125f;
#pragma unroll
      for (int d = 0; d < 64; ++d) { q[d] *= rs * qg[d]; o[d] = 0.f; }
    }
    float mx = p.attn_sink[l * 8 + hq], lsum = 1.f;
    for (int jj = 0; jj <= 256; ++jj) {
      int r = i + jj, kp = q0 - 128 + r;
      if (kp < 0 || kp >= S) continue;
      const h16x2* kr = (const h16x2*)(Ks + r * 66);
      float s = bias_s[gq * 257 + jj];
#pragma unroll
      for (int d = 0; d < 32; ++d) { h16x2 k2 = kr[d]; s += q[2 * d] * (float)k2[0] + q[2 * d + 1] * (float)k2[1]; }
      const h16x2* vr = (const h16x2*)(Vs + r * 66);
      if (s > mx) {
        float sc = __expf(mx - s);
        lsum = lsum * sc + 1.f;
#pragma unroll
        for (int d = 0; d < 32; ++d) { h16x2 v2 = vr[d]; o[2 * d] = o[2 * d] * sc + (float)v2[0]; o[2 * d + 1] = o[2 * d + 1] * sc + (float)v2[1]; }
        mx = s;
      } else {
        float pe = __expf(s - mx);
        lsum += pe;
#pragma unroll
        for (int d = 0; d < 32; ++d) { h16x2 v2 = vr[d]; o[2 * d] += pe * (float)v2[0]; o[2 * d + 1] += pe * (float)v2[1]; }
      }
    }
    float inv = 1.f / lsum;
#pragma unroll
    for (int c = 0; c < 64; c += 8) {
      h16x8 ov;
#pragma unroll
      for (int j = 0; j < 8; ++j) ov[j] = (h16)(o[c + j] * inv);
      *(h16x8*)(qp + c) = ov;
    }
    __syncthreads();
  }
}

__device__ void phase_gmlp(const Params& p, int l, char* shm) {
  CTX;
  h16* vn_s = (h16*)shm;
  h16* wT_s = vn_s + 128 * 130;
  const int tid = TIDX;
  const float* lng = p.gmlp_ln_g + l * 512;
  const float* lnb = p.gmlp_ln_b + l * 512;
  const int nitems = (TG / 128) * 4;
  for (int item = BIDX; item < nitems; item += gridDim.x) {
    const int grp = item & 3, t0 = (item >> 2) * 128;
    {
      const h16* w = p.wt + (size_t)l * WL + O_WSP + grp * 16384;
#pragma unroll
      for (int k = 0; k < 4; ++k) {
        int e = (tid + k * 512) * 8;
        int tt = e >> 7, s0 = e & 127;
        h16x8 wv = *(const h16x8*)(w + e);
#pragma unroll
        for (int j = 0; j < 8; ++j) wT_s[(s0 + j) * 128 + tt] = wv[j];
      }
    }
    {
      const int row = tid >> 2, part = tid & 3;
      const h16* rp = p.proj + (size_t)(t0 + row) * LDP + CGV;
      float sum = 0.f, sq = 0.f;
#pragma unroll 4
      for (int c = 0; c < 128; c += 8) {
        h16x8 v = *(const h16x8*)(rp + part * 128 + c);
#pragma unroll
        for (int j = 0; j < 8; ++j) { float ge = gelu_t((float)v[j]); sum += ge; sq += ge * ge; }
      }
      sum += __shfl_xor(sum, 1, 64); sum += __shfl_xor(sum, 2, 64);
      sq += __shfl_xor(sq, 1, 64); sq += __shfl_xor(sq, 2, 64);
      float mean = sum * (1.f / 512.f);
      float var = fmaxf(sq * (1.f / 512.f) - mean * mean, 0.f);
      float rstd = rsqrtf(var + EPS);
#pragma unroll
      for (int c = 0; c < 32; c += 8) {
        int cl = part * 32 + c;
        h16x8 v = *(const h16x8*)(rp + grp * 128 + cl);
#pragma unroll
        for (int j = 0; j < 8; ++j) {
          float ge = gelu_t((float)v[j]);
          vn_s[row * 130 + cl + j] = (h16)((ge - mean) * rstd * lng[grp * 128 + cl + j] + lnb[grp * 128 + cl + j]);
        }
      }
    }
    __syncthreads();
    {
      const int e = tid & 127, tq = tid >> 7;
      float acc[32];
#pragma unroll
      for (int i = 0; i < 32; ++i) acc[i] = 0.f;
      for (int s = 0; s < 128; ++s) {
        float v = (float)vn_s[s * 130 + e];
        const h16x8* wr8 = (const h16x8*)(wT_s + s * 128 + tq * 32);
#pragma unroll
        for (int k = 0; k < 4; ++k) {
          h16x8 w8 = wr8[k];
#pragma unroll
          for (int j = 0; j < 8; ++j) acc[k * 8 + j] += (float)w8[j] * v;
        }
      }
      const float* bs = p.b_spatial + (size_t)l * 512 + grp * 128;
#pragma unroll 4
      for (int tt = 0; tt < 32; ++tt) {
        int t = tq * 32 + tt;
        h16* up = p.proj + (size_t)(t0 + t) * LDP + CGU + grp * 128 + e;
        float u = gelu_t((float)*up);
        *up = (h16)(u * (acc[tt] + bs[t]));
      }
    }
    __syncthreads();
  }
}

__device__ void phase_ssd_rec(const Params& p, int g, int l, char* shm) {
  CTX;
  const int S = (g < 2) ? 2048 : 8192, nseq = TG / S;
  float* xs_s = (float*)shm;
  float* B_s = xs_s + 4096;
  float* C_s = B_s + 8192;
  float* dA_s = C_s + 8192;
  float* dt_s = dA_s + 64;
  float* y_s = dt_s + 64;
  const int tid = TIDX;
  const int nitems = nseq * 32;
  for (int item = BIDX; item < nitems; item += gridDim.x) {
    const int dir = item & 1, hd = (item >> 1) & 15, seq = item >> 5, grp = hd >> 3;
    const float a = -expf(p.a_log[l * 32 + dir * 16 + hd]);
    const int pq = tid >> 3, nq = tid & 7;
    h16* ybuf = dir ? p.bufB : p.bufA;
    float h[16];
#pragma unroll
    for (int n = 0; n < 16; ++n) h[n] = 0.f;
    for (int tb = 0; tb < S / 64; ++tb) {
      {
        int i = tid >> 3, c8 = (tid & 7) * 8;
        int t = dir ? (S - 1 - (tb * 64 + i)) : (tb * 64 + i);
        h16x8 v = *(const h16x8*)(p.xc + (size_t)(seq * S + t) * 1536 + hd * 64 + c8);
#pragma unroll
        for (int j = 0; j < 8; ++j) xs_s[i * 64 + c8 + j] = (float)v[j];
      }
#pragma unroll
      for (int k = 0; k < 2; ++k) {
        int task = tid + k * 512;
        int i = task >> 4, c8 = (task & 15) * 8;
        int t = dir ? (S - 1 - (tb * 64 + i)) : (tb * 64 + i);
        const h16* rp = p.xc + (size_t)(seq * S + t) * 1536 + 1024 + grp * 128 + c8;
        h16x8 bv = *(const h16x8*)rp, cv = *(const h16x8*)(rp + 256);
#pragma unroll
        for (int j = 0; j < 8; ++j) { B_s[i * 128 + c8 + j] = (float)bv[j]; C_s[i * 128 + c8 + j] = (float)cv[j]; }
      }
      if (tid < 64) {
        int t = dir ? (S - 1 - (tb * 64 + tid)) : (tb * 64 + tid);
        float dtv = p.dtbuf[(size_t)(seq * S + t) * 32 + dir * 16 + hd];
        dt_s[tid] = dtv;
        dA_s[tid] = expf(dtv * a);
      }
      __syncthreads();
      for (int i = 0; i < 64; ++i) {
        float dA = dA_s[i], xdt = xs_s[i * 64 + pq] * dt_s[i];
        const f32x4* b4 = (const f32x4*)(B_s + i * 128 + nq * 16);
        const f32x4* c4 = (const f32x4*)(C_s + i * 128 + nq * 16);
        float y = 0.f;
#pragma unroll
        for (int k = 0; k < 4; ++k) {
          f32x4 bb = b4[k], cc = c4[k];
#pragma unroll
          for (int j = 0; j < 4; ++j) { h[k * 4 + j] = h[k * 4 + j] * dA + xdt * bb[j]; y += h[k * 4 + j] * cc[j]; }
        }
        y += __shfl_xor(y, 1, 64); y += __shfl_xor(y, 2, 64); y += __shfl_xor(y, 4, 64);
        if (nq == 0) y_s[i * 64 + pq] = y;
      }
      __syncthreads();
      {
        int i = tid >> 3, c8 = (tid & 7) * 8;
        int t = dir ? (S - 1 - (tb * 64 + i)) : (tb * 64 + i);
        h16x8 ov;
#pragma unroll
        for (int j = 0; j < 8; ++j) ov[j] = (h16)y_s[i * 64 + c8 + j];
        *(h16x8*)(ybuf + (size_t)(seq * S + t) * 1024 + hd * 64 + c8) = ov;
      }
    }
    __syncthreads();
  }
}

__device__ void phase_ssd_fin(const Params& p, int l) {
  CTX;
  const int wid = TIDX >> 6, lane = TIDX & 63;
  for (int pair = BIDX * 8 + wid; pair < TG * 2; pair += gridDim.x * 8) {
    int t = pair >> 1, grp = pair & 1;
    int c = grp * 512 + lane * 8, hd = c >> 6;
    h16x8 yf = *(const h16x8*)(p.bufA + (size_t)t * 1024 + c), yb = *(const h16x8*)(p.bufB + (size_t)t * 1024 + c);
    h16x8 xv = *(const h16x8*)(p.xc + (size_t)t * 1536 + c);
    h16* zp = p.proj + (size_t)t * LDP + CZ + c;
    h16x8 zv = *(const h16x8*)zp;
    float Dk = p.d_skip[l * 16 + hd];
    float v[8], ss = 0.f;
#pragma unroll
    for (int j = 0; j < 8; ++j) {
      v[j] = ((float)yf[j] + (float)yb[j] + Dk * (float)xv[j]) * silu_f((float)zv[j]);
      ss += v[j] * v[j];
    }
    ss = wave_sum(ss);
    float rstd = rsqrtf(ss * (1.f / 512.f) + EPS);
    const float* ng = p.ssd_norm_g + l * 1024 + c;
    h16x8 ov;
#pragma unroll
    for (int j = 0; j < 8; ++j) ov[j] = (h16)(v[j] * rstd * ng[j]);
    *(h16x8*)zp = ov;
  }
}

__device__ void run_step(const Params& p, int s, char* shm) {
  if (s == 0) { phase_prep(p, shm); return; }
  s -= 1;
  const int g = s / 33, r = s % 33;
  if (r == 0) { phase_pre(p, g); return; }
  const int l = (r - 1) >> 3, ph = (r - 1) & 7;
  switch (ph) {
    case 0: phase_inproj(p, l, shm); break;
    case 1: phase_conv(p, g, l); phase_attn(p, g, l, shm); phase_gmlp(p, l, shm); break;
    case 2: phase_ssd_rec(p, g, l, shm); break;
    case 3: phase_ssd_fin(p, l); break;
    case 4: phase_merge(p, l, shm); break;
    case 5: phase_wout(p, g, l, shm); break;
    case 6: phase_ff1(p, l, shm); break;
    default: phase_ff2(p, g, l, shm); break;
  }
}

__device__ __forceinline__ unsigned long long rd_tab(const unsigned* tab, int i) {
  unsigned lo = __builtin_amdgcn_readfirstlane(tab[2 * i]), hi = __builtin_amdgcn_readfirstlane(tab[2 * i + 1]);
  return ((unsigned long long)hi << 32) | lo;
}

__global__ void __launch_bounds__(512, 2) mega(Params p) {
  extern __shared__ __attribute__((aligned(16))) char shm[];
  unsigned long long* tab = (unsigned long long*)(shm + SHM_GEMM + 1024);
  if (threadIdx.x == 0) {
#define X(i, T, n) tab[i] = (unsigned long long)p.n;
    PFIELDS(X)
#undef X
  }
  const int lo = p.step_lo, hi = p.step_hi;
  __syncthreads();
  for (int s = lo; s < hi; ++s) {
    if (s > lo) cg::this_grid().sync();
    Params q;
#define X(i, T, n) q.n = (T)rd_tab((const unsigned*)tab, i);
    PFIELDS(X)
#undef X
    q.step_lo = lo; q.step_hi = hi;
    run_step(q, s, shm);
  }
}

extern "C" void kernel_launch(void* const* d_in, const int* in_sizes, int n_in, void* d_out, int out_size, void* d_ws,
                              size_t ws_size, hipStream_t stream) {
  Params p{};
  {
    const float** fp = (const float**)&p;
    for (int i = 0; i < 25; ++i) fp[i] = (const float*)d_in[i];
  }
  p.out = (float*)d_out;
  char* ws = (char*)d_ws;
  size_t off = 0;
  p.wt = (h16*)(ws + off); off += (size_t)NLAYER * WL * 2;
  p.proj = (h16*)(ws + off); off += (size_t)TG * LDP * 2;
  p.bufA = (h16*)(ws + off); off += (size_t)TG * 1024 * 2;
  p.bufB = (h16*)(ws + off); off += (size_t)TG * 1024 * 2;
  p.xc = (h16*)(ws + off); off += (size_t)64 << 20;
  p.rssX = (float*)(ws + off); off += (size_t)TG * 4;
  p.rssH = (float*)(ws + off); off += (size_t)TG * 4;
  p.dtbuf = (float*)(ws + off); off += (size_t)TG * 32 * 4;
  static bool attr_set = false;
  if (!attr_set) {
    hipFuncSetAttribute((const void*)mega, hipFuncAttributeMaxDynamicSharedMemorySize, SHM_TOTAL);
    attr_set = true;
  }
#if MULTI_LAUNCH
  for (int s = 0; s < NSTEPS; ++s) {
    p.step_lo = s;
    p.step_hi = s + 1;
    hipLaunchKernelGGL(mega, dim3(256), dim3(512), SHM_TOTAL, stream, p);
  }
#else
  p.step_lo = 0;
  p.step_hi = NSTEPS;
  void* args[] = {&p};
  hipLaunchCooperativeKernel((void*)mega, dim3(256), dim3(512), args, SHM_TOTAL, stream);
#endif
}
```

```cpp
#include <hip/hip_runtime.h>
#include <hip/hip_fp16.h>
#include <hip/hip_cooperative_groups.h>
#include <type_traits>
namespace cg = cooperative_groups;

#ifndef MULTI_LAUNCH
#define MULTI_LAUNCH 0
#endif

typedef _Float16 h16;
using h16x8 = __attribute__((ext_vector_type(8))) _Float16;
using h16x4 = __attribute__((ext_vector_type(4))) _Float16;
using h16x2 = __attribute__((ext_vector_type(2))) _Float16;
using f32x4 = __attribute__((ext_vector_type(4))) float;

constexpr int LDP = 7456, TG = 16384, NLAYER = 4, LDH = 4160;
constexpr int CQ = 0, CK = 512, CV = 640, CGU = 768, CGV = 1280, CZ = 1792, CX = 2816, CDT = 4352, CG = 4384;
constexpr float EPS = 1e-6f;
constexpr long O_WIN = 0, O_UPA = 7456L * 1024, O_UPB = O_UPA + 524288, O_UPC = O_UPB + 524288, O_WOUT = O_UPC + 1048576,
               O_FF1 = O_WOUT + 1048576, O_FF2 = O_FF1 + 4194304, O_WSP = O_FF2 + 1024L * LDH, WL = O_WSP + 65536;
constexpr int SHM_GEMM = 131072, SHM_TOTAL = 163840, SHM_TAB = 162816;
constexpr int NSTEPS = 1 + 3 * 32;

#define PFIELDS(X)                                                                                                         \
  X(0, const float*, x_prompt) X(1, const float*, x_sample) X(2, const float*, rel_bias) X(3, const float*, norm_mix_g)    \
  X(4, const float*, w_in) X(5, const float*, q_norm_g) X(6, const float*, k_norm_g) X(7, const float*, attn_sink)         \
  X(8, const float*, gmlp_ln_g) X(9, const float*, gmlp_ln_b) X(10, const float*, w_spatial) X(11, const float*, b_spatial) \
  X(12, const float*, conv_w) X(13, const float*, conv_b) X(14, const float*, dt_bias) X(15, const float*, a_log)          \
  X(16, const float*, d_skip) X(17, const float*, ssd_norm_g) X(18, const float*, w_up_attn) X(19, const float*, w_up_gmlp) \
  X(20, const float*, w_up_ssd) X(21, const float*, w_out) X(22, const float*, norm_ff_g) X(23, const float*, w_ff1)       \
  X(24, const float*, w_ff2) X(25, float*, out) X(26, h16*, wt) X(27, h16*, proj) X(28, h16*, bufA) X(29, h16*, bufB)      \
  X(30, h16*, st) X(31, float*, rssX) X(32, float*, rssH) X(33, float*, dtbuf) X(34, float*, dec) X(35, float*, ssq) X(36, unsigned*, bar)
struct Params {
#define X(i, T, n) T n;
  PFIELDS(X)
#undef X
  int step_lo, step_hi;
};

__device__ __forceinline__ float wave_sum(float v) {
#pragma unroll
  for (int o = 32; o > 0; o >>= 1) v += __shfl_xor(v, o, 64);
  return v;
}
__device__ __forceinline__ float gelu_t(float x) {
  float u2 = 1.5957691216057308f * (x + 0.044715f * x * x * x);
  return x * __builtin_amdgcn_rcpf(1.f + __expf(-u2));
}
__device__ __forceinline__ float silu_f(float x) { return x * __builtin_amdgcn_rcpf(1.f + __expf(-x)); }
__device__ __forceinline__ float clampf(float x, float lo, float hi) { return fminf(fmaxf(x, lo), hi); }

__device__ __forceinline__ int opaque_tid() { int t = threadIdx.x; asm volatile("" : "+v"(t)); return t; }
__device__ __forceinline__ int opaque_bid() { int b = blockIdx.x; asm volatile("" : "+s"(b)); return b; }
#define CTX const int TIDX = opaque_tid(); const int BIDX = opaque_bid(); (void)TIDX; (void)BIDX

__device__ void prep_tile(const float* __restrict__ src, int K, int N, h16* __restrict__ dst, const float* __restrict__ scale,
                          int nt, int kt, char* shm, int ldd = 0) {
  CTX;
  float(*tile)[65] = (float(*)[65])shm;
  const int tid = TIDX;
  const int n0 = nt * 64, k0 = kt * 64;
  {
    int nn = tid & 63, kk0 = tid >> 6;
#pragma unroll
    for (int i = 0; i < 8; ++i) {
      int kk = kk0 + 8 * i;
      float v = 0.f;
      if (n0 + nn < N) {
        v = src[(size_t)(k0 + kk) * N + n0 + nn];
        if (scale) v *= scale[k0 + kk];
      }
      tile[kk][nn] = v;
    }
  }
  __syncthreads();
  {
    int kk = tid & 63, nn0 = tid >> 6;
#pragma unroll
    for (int i = 0; i < 8; ++i) {
      int nn = nn0 + 8 * i;
      if (n0 + nn < N) dst[(size_t)(n0 + nn) * (ldd ? ldd : K) + k0 + kk] = (h16)tile[kk][nn];
    }
  }
  __syncthreads();
}

__device__ void phase_prep(const Params& p, char* shm) {
  CTX;
  constexpr int T_IN = 117 * 16, T_UA = 16 * 8, T_UC = 16 * 16, T_F = 64 * 16, T_SP = 16;
  constexpr int PER = T_IN + 2 * T_UA + 2 * T_UC + 2 * T_F + T_SP;
  for (int item = BIDX; item < PER * NLAYER; item += gridDim.x) {
    int l = item / PER, r = item % PER;
    h16* wl = p.wt + (size_t)l * WL;
    if (r < T_IN) { prep_tile(p.w_in + (size_t)l * 1024 * LDP, 1024, LDP, wl + O_WIN, p.norm_mix_g + l * 1024, r / 16, r % 16, shm); continue; }
    r -= T_IN;
    if (r < T_UA) { prep_tile(p.w_up_attn + (size_t)l * 512 * 1024, 512, 1024, wl + O_UPA, nullptr, r / 8, r % 8, shm); continue; }
    r -= T_UA;
    if (r < T_UA) { prep_tile(p.w_up_gmlp + (size_t)l * 512 * 1024, 512, 1024, wl + O_UPB, nullptr, r / 8, r % 8, shm); continue; }
    r -= T_UA;
    if (r < T_UC) { int hf = r >> 7, rr = r & 127; prep_tile(p.w_up_ssd + (size_t)l * 1024 * 1024 + (size_t)hf * 512 * 1024, 512, 1024, wl + O_UPC + hf * 524288, p.ssd_norm_g + l * 1024 + hf * 512, rr / 8, rr % 8, shm); continue; }
    r -= T_UC;
    if (r < T_UC) { prep_tile(p.w_out + (size_t)l * 1024 * 1024, 1024, 1024, wl + O_WOUT, nullptr, r / 16, r % 16, shm); continue; }
    r -= T_UC;
    if (r < T_F) { prep_tile(p.w_ff1 + (size_t)l * 1024 * 4096, 1024, 4096, wl + O_FF1, p.norm_ff_g + l * 1024, r / 16, r % 16, shm); continue; }
    r -= T_F;
    if (r < T_F) { prep_tile(p.w_ff2 + (size_t)l * 4096 * 1024, 4096, 1024, wl + O_FF2, nullptr, r / 64, r % 64, shm, LDH); continue; }
    r -= T_F;
    {
      const float* s = p.w_spatial + (size_t)l * 65536 + r * 4096;
      h16* d = wl + O_WSP + r * 4096;
      for (int i = TIDX; i < 4096; i += 512) d[i] = (h16)s[i];
    }
  }
}

__device__ void phase_pre(const Params& p, int g) {
  CTX;
  const float* xin = (g < 2) ? p.x_prompt + (size_t)g * TG * 1024 : p.x_sample;
  float* xo = p.out + (size_t)g * TG * 1024;
  const int wid = TIDX >> 6, lane = TIDX & 63;
  for (int row = BIDX * 8 + wid; row < TG; row += gridDim.x * 8) {
    const float4* s4 = (const float4*)(xin + (size_t)row * 1024);
    float4* d4 = (float4*)(xo + (size_t)row * 1024);
    float ss = 0.f;
#pragma unroll
    for (int i = 0; i < 4; ++i) {
      int idx = i * 64 + lane;
      float4 v = s4[idx];
      d4[idx] = v;
      ss += v.x * v.x + v.y * v.y + v.z * v.z + v.w * v.w;
      h16x4 hv = {(h16)v.x, (h16)v.y, (h16)v.z, (h16)v.w};
      *(h16x4*)(p.bufA + (size_t)row * 1024 + idx * 4) = hv;
    }
    ss = wave_sum(ss);
    if (lane == 0) p.rssX[row] = ss;
  }
}

#define LAS __attribute__((address_space(3)))
constexpr int BK = 64, HALF = 128, HTB = HALF * BK * 2;
__device__ __forceinline__ int lds_byte(int r, int c) {
  const int st = (r >> 4) * 2 + (c >> 5), rr = r & 15, cc = c & 31, ob = rr * 64 + cc * 2;
  return st * 1024 + (ob ^ (((ob >> 9) & 1) << 5));
}
__device__ __forceinline__ void stage_rc(int b, int& R, int& C) {
  const int st = b / 1024, sb = b % 1024, swz = sb ^ (((sb >> 9) & 1) << 5);
  R = (st >> 1) * 16 + swz / 64;
  C = (st & 1) * 32 + (swz % 64) / 2;
}
__device__ __forceinline__ int perm32(int rho) { const int n = rho >> 4, i = rho & 15; return 8 * (i >> 2) + 4 * n + (i & 3); }

struct Unit { const char* A; const char* B; int pm, pn, seg; };

__device__ __forceinline__ void tile_map(int t, int total, int nN, int& pm, int& pn) {
  int base = t & ~255, i = t & 255;
  int R = min(256, total - base);
  int id = (R & 7) ? t : base + (i & 7) * (R >> 3) + (i >> 3);
  int band = id / (8 * nN), w = id % (8 * nN);
  pm = band * 8 + (w & 7);
  pn = w >> 3;
}

template <class Sched, class Epi>
__device__ __forceinline__ void gemm_phase(LAS unsigned char* lds, const int lda, const int ldb, const int nt, const Sched& S, const Epi& E) {
  CTX;
  const int tid = TIDX, wid = __builtin_amdgcn_readfirstlane(tid >> 6), lane = tid & 63, wr = wid >> 2, wc = wid & 3, fr = lane & 15, fq = lane >> 4;
  unsigned voffA[2], voffB[2];
#pragma unroll
  for (int i = 0; i < 2; ++i) {
    int R, C;
    stage_rc(tid * 16 + i * 8192, R, C);
    const int Rb = (R & ~31) + perm32(R & 31);
    voffA[i] = (unsigned)(R * lda + C) * 2u;
    voffB[i] = (unsigned)(Rb * ldb + C) * 2u;
  }
  const size_t kstep = (size_t)(BK * 2);
  const size_t hstepA = (size_t)HALF * lda * 2, hstepB = (size_t)HALF * ldb * 2;
  const unsigned ldsw = (unsigned)wid * 1024u;
  const int aoff = lds_byte(wr * 64 + fr, fq * 8), boff = lds_byte(wc * 32 + fr, fq * 8);
#define G_SA(b, h) (((b)*2 + (h)) * HTB)
#define G_SB(b, h) ((4 + (b)*2 + (h)) * HTB)
#define G_STAGE(bufoff, gbase, voff)                                                                                        \
  do {                                                                                                                      \
    _Pragma("unroll") for (int _i = 0; _i < 2; ++_i) __builtin_amdgcn_global_load_lds(                                      \
        (const unsigned*)((const char*)(gbase) + (voff)[_i]), (LAS unsigned*)(lds + (bufoff) + ldsw + _i * 8192), 16, 0, 0); \
  } while (0)
#define G_LDA(dst, b, h)                                                                                                    \
  do {                                                                                                                      \
    _Pragma("unroll") for (int m = 0; m < 4; ++m) _Pragma("unroll") for (int k = 0; k < 2; ++k) dst[m][k] =                 \
        *(const LAS h16x8*)(lds + G_SA(b, h) + aoff + m * 2048 + k * 1024);                                                 \
  } while (0)
#define G_LDB(dst, b, h)                                                                                                    \
  do {                                                                                                                      \
    _Pragma("unroll") for (int n = 0; n < 2; ++n) _Pragma("unroll") for (int k = 0; k < 2; ++k) dst[n][k] =                 \
        *(const LAS h16x8*)(lds + G_SB(b, h) + boff + n * 2048 + k * 1024);                                                 \
  } while (0)
#define G_MMA(ai, bj, At_, Bt_)                                                                                             \
  do {                                                                                                                      \
    __builtin_amdgcn_s_setprio(1);                                                                                          \
    _Pragma("unroll") for (int m = 0; m < 4; ++m) _Pragma("unroll") for (int n = 0; n < 2; ++n)                             \
    _Pragma("unroll") for (int k = 0; k < 2; ++k) acc[ai][bj][m][n] =                                                       \
        __builtin_amdgcn_mfma_f32_16x16x32_f16(Bt_[n][k], At_[m][k], acc[ai][bj][m][n], 0, 0, 0);                           \
    __builtin_amdgcn_s_setprio(0);                                                                                          \
  } while (0)
#define G_WAIT_V(n) asm volatile("s_waitcnt vmcnt(" #n ")" ::: "memory")
#define G_WAIT_L(n) asm volatile("s_waitcnt lgkmcnt(" #n ")" ::: "memory")
#define G_BAR __builtin_amdgcn_s_barrier()
#define G_SCHED __builtin_amdgcn_sched_barrier(0)
#define G_ZERO                                                                                       \
  _Pragma("unroll") for (int a = 0; a < 2; ++a) _Pragma("unroll") for (int b = 0; b < 2; ++b)        \
  _Pragma("unroll") for (int m = 0; m < 4; ++m) _Pragma("unroll") for (int n = 0; n < 2; ++n) acc[a][b][m][n] = f32x4{0.f, 0.f, 0.f, 0.f}
  Unit cur, nxt;
  int ui = 0;
  if (!S.next(0, cur)) return;
  f32x4 acc[2][2][4][2];
  G_ZERO;
  h16x8 At[4][2], B0[2][2], B1[2][2];
  const char* cA = cur.A;
  const char* cB = cur.B;
  G_STAGE(G_SB(0, 0), cB, voffB); G_STAGE(G_SA(0, 0), cA, voffA); G_STAGE(G_SB(0, 1), cB + hstepB, voffB); G_STAGE(G_SA(0, 1), cA + hstepA, voffA);
  if (wr == 1) G_BAR;
  G_WAIT_V(4); G_BAR;
  G_STAGE(G_SB(1, 0), cB + kstep, voffB); G_STAGE(G_SA(1, 0), cA + kstep, voffA); G_STAGE(G_SB(1, 1), cB + hstepB + kstep, voffB);
  G_WAIT_V(6); G_BAR;
  for (;;) {
    const typename Epi::Pre pre = E.prefetch(cur, wr, fr);
    const bool has_next = S.next(ui + 1, nxt);
    const char* nA = has_next ? nxt.A : cA;
    const char* nB = has_next ? nxt.B : cB;
    for (int t = 0; t < nt; t += 2) {
      const bool last = (t == nt - 2);
      const char* a1 = cA + (size_t)(t + 1) * kstep;
      const char* a2 = last ? nA : cA + (size_t)(t + 2) * kstep;
      const char* b2 = last ? nB : cB + (size_t)(t + 2) * kstep;
      const char* a3 = a2 + kstep;
      const char* b3 = b2 + kstep;
      G_LDB(B0, 0, 0); G_SCHED; G_LDA(At, 0, 0); G_STAGE(G_SA(1, 1), a1 + hstepA, voffA);
      G_WAIT_L(8); G_BAR; G_WAIT_L(0); G_MMA(0, 0, At, B0); G_BAR; G_SCHED;
      G_LDB(B1, 0, 1); G_STAGE(G_SB(0, 0), b2, voffB);
      G_BAR; G_WAIT_L(0); G_MMA(0, 1, At, B1); G_BAR;
      G_LDA(At, 0, 1); G_STAGE(G_SA(0, 0), a2, voffA);
      G_BAR; G_WAIT_L(0); G_MMA(1, 0, At, B0); G_BAR; G_SCHED;
      G_STAGE(G_SB(0, 1), b2 + hstepB, voffB);
      G_WAIT_V(6); G_BAR; G_MMA(1, 1, At, B1); G_BAR;
      G_LDB(B0, 1, 0); G_SCHED; G_LDA(At, 1, 0); G_STAGE(G_SA(0, 1), a2 + hstepA, voffA);
      G_WAIT_L(8); G_BAR; G_WAIT_L(0); G_MMA(0, 0, At, B0); G_BAR; G_SCHED;
      G_LDB(B1, 1, 1); G_STAGE(G_SB(1, 0), b3, voffB);
      G_BAR; G_WAIT_L(0); G_MMA(0, 1, At, B1); G_BAR;
      G_LDA(At, 1, 1); G_STAGE(G_SA(1, 0), a3, voffA);
      G_BAR; G_WAIT_L(0); G_MMA(1, 0, At, B0); G_BAR; G_SCHED;
      G_STAGE(G_SB(1, 1), b3 + hstepB, voffB);
      G_WAIT_V(6); G_BAR; G_MMA(1, 1, At, B1); G_BAR;
    }
    int fr_o = fr, fq_o = fq;
    asm volatile("" : "+v"(fr_o), "+v"(fq_o));
    const bool clr = E(acc, cur, pre, wr, wc, fr_o, fq_o);
    if (!has_next) break;
    if (clr) { G_ZERO; }
    cur = nxt; cA = nA; cB = nB; ++ui;
  }
  G_WAIT_V(0);
  if (wr == 0) G_BAR;
  G_BAR;
}

struct SchedTiles {
  const char *A, *B; size_t tstepA, tstepB; int nN, total, G, c;
  __device__ __forceinline__ bool next(int i, Unit& u) const {
    const long L = (long)i * G + c;
    if (L >= total) return false;
    tile_map((int)L, total, nN, u.pm, u.pn);
    u.A = A + (size_t)u.pm * tstepA; u.B = B + (size_t)u.pn * tstepB; u.seg = 0;
    return true;
  }
};
struct SchedMerge {
  const char *proj, *wl; int G, c;
  __device__ __forceinline__ bool next(int i, Unit& u) const {
    const int tile = (i >> 2) * G + c;
    if (tile >= 256) return false;
    const int seg = i & 3;
    tile_map(tile, 256, 4, u.pm, u.pn);
    const int acol = seg == 0 ? CQ : seg == 1 ? CGU : seg == 2 ? CZ : CZ + 512;
    const long bo = seg == 0 ? O_UPA : seg == 1 ? O_UPB : seg == 2 ? O_UPC : O_UPC + 524288;
    u.A = proj + ((size_t)u.pm * 256 * LDP + acol) * 2;
    u.B = wl + ((size_t)bo + (size_t)u.pn * 256 * 512) * 2;
    u.seg = seg;
    return true;
  }
};

#define FOR_ROWS _Pragma("unroll") for (int ai = 0; ai < 2; ++ai) _Pragma("unroll") for (int m = 0; m < 4; ++m)
__device__ __forceinline__ h16x8 pack8(f32x4 a, f32x4 b) {
  h16x8 r = {(h16)a[0], (h16)a[1], (h16)a[2], (h16)a[3], (h16)b[0], (h16)b[1], (h16)b[2], (h16)b[3]};
  return r;
}

struct EpiInproj {
  h16* proj; float* dtbuf; const float* rss;
  struct Pre { float v[8]; };
  __device__ __forceinline__ Pre prefetch(const Unit& u, int wr, int fr) const {
    Pre q;
    const int row0 = u.pm * 256 + wr * 64 + fr;
#pragma unroll
    for (int r8 = 0; r8 < 8; ++r8) q.v[r8] = rss[row0 + (r8 >> 2) * 128 + (r8 & 3) * 16];
    return q;
  }
  __device__ __forceinline__ bool operator()(f32x4 (&acc)[2][2][4][2], const Unit& u, const Pre& pre, int wr, int wc, int fr, int fq) const {
    const int row0 = u.pm * 256 + wr * 64 + fr, col0 = u.pn * 256 + wc * 32 + 8 * fq;
    FOR_ROWS {
      const size_t row = row0 + ai * 128 + m * 16;
      const float rs = rsqrtf(pre.v[ai * 4 + m] * (1.f / 1024.f) + EPS);
      h16* rp = proj + row * LDP + col0;
#pragma unroll
      for (int bj = 0; bj < 2; ++bj) {
        const int col = col0 + bj * 128;
        if (col < LDP) {
          f32x4 v0 = acc[ai][bj][m][0] * rs, v1 = acc[ai][bj][m][1] * rs;
          if (col >= CG) {
#pragma unroll
            for (int j = 0; j < 4; ++j) {
              v0[j] = fmaxf(__builtin_amdgcn_rcpf(1.f + __expf(-v0[j])), 6.2e-5f);
              v1[j] = fmaxf(__builtin_amdgcn_rcpf(1.f + __expf(-v1[j])), 6.2e-5f);
            }
          }
          *(h16x8*)(rp + bj * 128) = pack8(v0, v1);
          if (col >= CDT && col < CDT + 32) {
            *(f32x4*)(dtbuf + row * 32 + (col - CDT)) = v0;
            *(f32x4*)(dtbuf + row * 32 + (col - CDT) + 4) = v1;
          }
        }
      }
    }
    return true;
  }
};

__device__ __forceinline__ float sig_ratio(float a, float b) {
  a = clampf(a, -30.f, 30.f);
  b = clampf(b, -30.f, 30.f);
  return (1.f + __expf(-b)) / (1.f + __expf(-a));
}
struct EpiMerge {
  const h16* proj; h16* dst; const float* ssq;
  struct Pre {};
  __device__ __forceinline__ Pre prefetch(const Unit&, int, int) const { return Pre{}; }
  __device__ __forceinline__ bool operator()(f32x4 (&acc)[2][2][4][2], const Unit& u, const Pre& pre, int wr, int wc, int fr, int fq) const {
    const int row0 = u.pm * 256 + wr * 64 + fr, col0 = u.pn * 256 + wc * 32 + 8 * fq;
    const int seg = u.seg;
    const int go = (seg == 3) ? 2048 : seg * 1024;
    const h16x8 one = {1, 1, 1, 1, 1, 1, 1, 1};
    float2 sq[8];
#pragma unroll
    for (int r8 = 0; r8 < 8; ++r8) sq[r8] = *(const float2*)(ssq + (size_t)(row0 + (r8 >> 2) * 128 + (r8 & 3) * 16) * 2);
    h16x8 c0[2] = {one, one}, c1[2] = {one, one}, n0[2] = {one, one}, n1[2] = {one, one};
    {
      const h16* gp = proj + (size_t)row0 * LDP + CG + col0 + go;
      if (seg != 2) { c0[0] = *(const h16x8*)gp; c0[1] = *(const h16x8*)(gp + 128); }
      if (seg < 2) { c1[0] = *(const h16x8*)(gp + 1024); c1[1] = *(const h16x8*)(gp + 1024 + 128); }
    }
#pragma unroll
    for (int r8 = 0; r8 < 8; ++r8) {
      const int ai = r8 >> 2, m = r8 & 3;
      const size_t row = row0 + ai * 128 + m * 16;
      if (r8 < 7) {
        const h16* gp = proj + (size_t)(row0 + ((r8 + 1) >> 2) * 128 + ((r8 + 1) & 3) * 16) * LDP + CG + col0 + go;
        if (seg != 2) { n0[0] = *(const h16x8*)gp; n0[1] = *(const h16x8*)(gp + 128); }
        if (seg < 2) { n1[0] = *(const h16x8*)(gp + 1024); n1[1] = *(const h16x8*)(gp + 1024 + 128); }
      }
      const float q0 = sq[r8].x * (1.f / 512.f) + EPS, q1 = sq[r8].y * (1.f / 512.f) + EPS;
      const float f = (seg == 0) ? 1.f : (seg == 1) ? sqrtf(q0) : (seg == 2) ? rsqrtf(q0) * sqrtf(q1) : rsqrtf(q1);
#pragma unroll
      for (int bj = 0; bj < 2; ++bj) {
#pragma unroll
        for (int j = 0; j < 4; ++j) {
          acc[ai][bj][m][0][j] *= (float)c0[bj][j] * __builtin_amdgcn_rcpf((float)c1[bj][j]) * f;
          acc[ai][bj][m][1][j] *= (float)c0[bj][4 + j] * __builtin_amdgcn_rcpf((float)c1[bj][4 + j]) * f;
        }
        if (seg == 3) *(h16x8*)(dst + row * 1024 + col0 + bj * 128) = pack8(acc[ai][bj][m][0], acc[ai][bj][m][1]);
      }
#pragma unroll
      for (int k = 0; k < 2; ++k) { c0[k] = n0[k]; c1[k] = n1[k]; }
    }
    return seg == 3;
  }
};

struct EpiResid {
  float* xo; h16* copy; float* rss; int feed;
  struct Pre {};
  __device__ __forceinline__ Pre prefetch(const Unit&, int, int) const { return Pre{}; }
  __device__ __forceinline__ bool operator()(f32x4 (&acc)[2][2][4][2], const Unit& u, const Pre& pre, int wr, int wc, int fr, int fq) const {
    const int row0 = u.pm * 256 + wr * 64 + fr, col0 = u.pn * 256 + wc * 32 + 8 * fq;
    f32x4 cur[4], nxt[4];
    {
      const float* xp = xo + (size_t)row0 * 1024 + col0;
      cur[0] = *(const f32x4*)xp; cur[1] = *(const f32x4*)(xp + 4); cur[2] = *(const f32x4*)(xp + 128); cur[3] = *(const f32x4*)(xp + 132);
    }
#pragma unroll
    for (int r8 = 0; r8 < 8; ++r8) {
      const int ai = r8 >> 2, m = r8 & 3;
      const size_t row = row0 + ai * 128 + m * 16;
      if (r8 < 7) {
        const float* xp = xo + (size_t)(row0 + ((r8 + 1) >> 2) * 128 + ((r8 + 1) & 3) * 16) * 1024 + col0;
        nxt[0] = *(const f32x4*)xp; nxt[1] = *(const f32x4*)(xp + 4); nxt[2] = *(const f32x4*)(xp + 128); nxt[3] = *(const f32x4*)(xp + 132);
      }
      float ss = 0.f;
#pragma unroll
      for (int bj = 0; bj < 2; ++bj) {
        float* xp = xo + row * 1024 + col0 + bj * 128;
        f32x4 v0 = cur[bj * 2] + acc[ai][bj][m][0], v1 = cur[bj * 2 + 1] + acc[ai][bj][m][1];
        *(f32x4*)xp = v0;
        *(f32x4*)(xp + 4) = v1;
        if (feed) *(h16x8*)(copy + row * 1024 + col0 + bj * 128) = pack8(v0, v1);
#pragma unroll
        for (int j = 0; j < 4; ++j) ss += v0[j] * v0[j] + v1[j] * v1[j];
      }
      ss += __shfl_xor(ss, 16, 64);
      ss += __shfl_xor(ss, 32, 64);
      if (fq == 0 && feed) atomicAdd(rss + row, ss);
#pragma unroll
      for (int k = 0; k < 4; ++k) cur[k] = nxt[k];
    }
    return true;
  }
};

struct EpiFF1 {
  h16* hid; const float* rss;
  struct Pre { float v[8]; };
  __device__ __forceinline__ Pre prefetch(const Unit& u, int wr, int fr) const {
    Pre q;
    const int row0 = u.pm * 256 + wr * 64 + fr;
#pragma unroll
    for (int r8 = 0; r8 < 8; ++r8) q.v[r8] = rss[row0 + (r8 >> 2) * 128 + (r8 & 3) * 16];
    return q;
  }
  __device__ __forceinline__ bool operator()(f32x4 (&acc)[2][2][4][2], const Unit& u, const Pre& pre, int wr, int wc, int fr, int fq) const {
    const int row0 = u.pm * 256 + wr * 64 + fr, col0 = u.pn * 256 + wc * 32 + 8 * fq;
    FOR_ROWS {
      const size_t row = row0 + ai * 128 + m * 16;
      const float rs = rsqrtf(pre.v[ai * 4 + m] * (1.f / 1024.f) + EPS);
#pragma unroll
      for (int bj = 0; bj < 2; ++bj) {
        f32x4 v0 = acc[ai][bj][m][0] * rs, v1 = acc[ai][bj][m][1] * rs;
#pragma unroll
        for (int j = 0; j < 4; ++j) {
          float a = fmaxf(v0[j], 0.f), b = fmaxf(v1[j], 0.f);
          v0[j] = a * a; v1[j] = b * b;
        }
        *(h16x8*)(hid + row * LDH + col0 + bj * 128) = pack8(v0, v1);
      }
    }
    return true;
  }
};

__device__ __forceinline__ void zero_f32(float* p, int n) {
  CTX;
  for (int i = BIDX * 512 + TIDX; i < n; i += gridDim.x * 512) p[i] = 0.f;
}

__device__ void phase_inproj(const Params& p, int l, char* shm) {
  CTX;
  zero_f32(p.rssH, TG);
  SchedTiles S{(const char*)p.bufA, (const char*)(p.wt + (size_t)l * WL + O_WIN), (size_t)256 * 1024 * 2, (size_t)256 * 1024 * 2, 30, 64 * 30, (int)gridDim.x, (int)BIDX};
  EpiInproj E{p.proj, p.dtbuf, p.rssX};
  gemm_phase((LAS unsigned char*)shm, 1024, 1024, 16, S, E);
}
__device__ void phase_merge(const Params& p, int l, char* shm) {
  CTX;
  SchedMerge S{(const char*)p.proj, (const char*)(p.wt + (size_t)l * WL), (int)gridDim.x, (int)BIDX};
  EpiMerge E{p.proj, p.bufA, p.ssq};
  gemm_phase((LAS unsigned char*)shm, LDP, 512, 8, S, E);
}
__device__ void phase_wout(const Params& p, int g, int l, char* shm) {
  CTX;
  SchedTiles S{(const char*)p.bufA, (const char*)(p.wt + (size_t)l * WL + O_WOUT), (size_t)256 * 1024 * 2, (size_t)256 * 1024 * 2, 4, 256, (int)gridDim.x, (int)BIDX};
  EpiResid E{p.out + (size_t)g * TG * 1024, p.bufB, p.rssH, 1};
  gemm_phase((LAS unsigned char*)shm, 1024, 1024, 16, S, E);
}
__device__ void phase_ff1(const Params& p, int l, char* shm) {
  CTX;
  zero_f32(p.rssX, TG);
  SchedTiles S{(const char*)p.bufB, (const char*)(p.wt + (size_t)l * WL + O_FF1), (size_t)256 * 1024 * 2, (size_t)256 * 1024 * 2, 16, 64 * 16, (int)gridDim.x, (int)BIDX};
  EpiFF1 E{p.proj, p.rssH};
  gemm_phase((LAS unsigned char*)shm, 1024, 1024, 16, S, E);
}
__device__ void phase_ff2(const Params& p, int g, int l, char* shm) {
  CTX;
  SchedTiles S{(const char*)p.proj, (const char*)(p.wt + (size_t)l * WL + O_FF2), (size_t)256 * LDH * 2, (size_t)256 * LDH * 2, 4, 256, (int)gridDim.x, (int)BIDX};
  EpiResid E{p.out + (size_t)g * TG * 1024, p.bufA, p.rssX, l < NLAYER - 1};
  gemm_phase((LAS unsigned char*)shm, LDH, LDH, 64, S, E);
}

__device__ __forceinline__ int t5_bucket(int rel) {
  int ret = rel > 0 ? 16 : 0;
  int n = rel < 0 ? -rel : rel;
  if (n < 8) return ret + n;
  int large = 8;
#pragma unroll
  for (int k = 1; k <= 7; ++k) large += (n * n >= (64 << k)) ? 1 : 0;
  return ret + min(large, 15);
}

__device__ void phase_attn(const Params& p, int g, int l, char* shm, int dry) {
  CTX;
  const int S = (g < 2) ? 2048 : 8192;
  constexpr int KS = 72, KP = 408;
  h16* Ks = (h16*)shm;
  h16* VT = Ks + 384 * KS;
  float* bias_s = (float*)(VT + 64 * KP);
  const int wid = TIDX >> 6, lane = TIDX & 63, fr = lane & 15, fq = lane >> 4;
  const float* kg = p.k_norm_g + l * 64;
  const float* qg = p.q_norm_g + l * 64;
  const int nitems = (TG / 128) * 2;
  for (int item = BIDX; item < nitems; item += gridDim.x) {
    const int hk = item & 1, blk = item >> 1;
    const int t0 = blk * 128, seq = t0 / S, q0 = t0 % S;
#pragma unroll
    for (int i = TIDX; i < 4 * 257; i += 512) {
      int gq = i / 257, rel = i % 257 - 128;
      bias_s[i] = p.rel_bias[t5_bucket(rel) * 8 + hk * 4 + gq];
    }
    const int gq = wid >> 1, hq = hk * 4 + gq;
    h16x8 qa_n, qb_n;
    {
      const h16* qr0 = p.proj + (size_t)(seq * S + q0 + (wid & 1) * 64 + fr) * LDP + CQ + hq * 64;
      qa_n = *(const h16x8*)(qr0 + fq * 8); qb_n = *(const h16x8*)(qr0 + 32 + fq * 8);
    }
    float qgA[8], qgB[8];
#pragma unroll
    for (int j = 0; j < 8; ++j) { qgA[j] = qg[fq * 8 + j]; qgB[j] = qg[32 + fq * 8 + j]; }
    for (int i = TIDX; i < 64 * 24; i += 512) VT[(i / 24) * KP + 384 + (i % 24)] = (h16)0.f;
    {
      h16x8 kvr[6], vvr[6];
#pragma unroll
      for (int k = 0; k < 6; ++k) {
        int task = TIDX + k * 512, r = task >> 3, c = (task & 7) * 8;
        int kp = q0 - 128 + r;
        const h16x8 zero = {0, 0, 0, 0, 0, 0, 0, 0};
        const bool valid = (kp >= 0) && (kp < S);
        const h16* rp = p.proj + (size_t)(seq * S + min(max(kp, 0), S - 1)) * LDP;
        kvr[k] = *(const h16x8*)(rp + CK + hk * 64 + c);
        vvr[k] = *(const h16x8*)(rp + CV + hk * 64 + c);
        kvr[k] = valid ? kvr[k] : zero;
        vvr[k] = valid ? vvr[k] : zero;
      }
#pragma unroll
      for (int k = 0; k < 6; ++k) {
        int task = TIDX + k * 512, r = task >> 3, c = (task & 7) * 8;
        float kf[8], ss = 0.f;
#pragma unroll
        for (int j = 0; j < 8; ++j) { kf[j] = (float)kvr[k][j]; ss += kf[j] * kf[j]; }
        ss += __shfl_xor(ss, 1, 64);
        ss += __shfl_xor(ss, 2, 64);
        ss += __shfl_xor(ss, 4, 64);
        float rs = rsqrtf(ss * (1.f / 64.f) + EPS);
        h16x8 kn;
#pragma unroll
        for (int j = 0; j < 8; ++j) { kn[j] = (h16)(kf[j] * rs * kg[c + j]); VT[(c + j) * KP + r] = vvr[k][j]; }
        *(h16x8*)(Ks + r * KS + c) = kn;
      }
    }
    __syncthreads();
    const bool edge = (q0 == 0) || (q0 == S - 128);
    const float sinkv = p.attn_sink[l * 8 + hq];
#pragma unroll 1
    for (int qi = 0; qi < 4; ++qi) {
      const int qt = (wid & 1) * 4 + qi, i = qt * 16 + fr;
      h16* qrow = p.proj + (size_t)(seq * S + q0 + i) * LDP + CQ + hq * 64;
      h16x8 qa = qa_n, qb = qb_n;
      if (qi < 3) {
        const h16* qrn = qrow + (size_t)16 * LDP;
        qa_n = *(const h16x8*)(qrn + fq * 8); qb_n = *(const h16x8*)(qrn + 32 + fq * 8);
      }
      {
        float ss = 0.f;
#pragma unroll
        for (int j = 0; j < 8; ++j) ss += (float)qa[j] * (float)qa[j] + (float)qb[j] * (float)qb[j];
        ss += __shfl_xor(ss, 16, 64);
        ss += __shfl_xor(ss, 32, 64);
        const float rs = rsqrtf(ss * (1.f / 64.f) + EPS) * 0.125f;
#pragma unroll
        for (int j = 0; j < 8; ++j) {
          qa[j] = (h16)((float)qa[j] * rs * qgA[j]);
          qb[j] = (h16)((float)qb[j] * rs * qgB[j]);
        }
      }
      f32x4 sc[18];
#pragma unroll
      for (int kt = 0; kt < 17; ++kt) {
        const h16* kr = Ks + ((qt + kt) * 16 + fr) * KS + fq * 8;
        f32x4 acc = {0.f, 0.f, 0.f, 0.f};
        acc = __builtin_amdgcn_mfma_f32_16x16x32_f16(*(const h16x8*)kr, qa, acc, 0, 0, 0);
        acc = __builtin_amdgcn_mfma_f32_16x16x32_f16(*(const h16x8*)(kr + 32), qb, acc, 0, 0, 0);
        sc[kt] = acc;
      }
      sc[17] = f32x4{0.f, 0.f, 0.f, 0.f};
      float mx = sinkv;
      const int d0 = 4 * fq - fr;
      const float* bl = bias_s + gq * 257 + d0;
      if (!edge) {
#pragma unroll
        for (int kt = 0; kt < 17; ++kt) {
#pragma unroll
          for (int j = 0; j < 4; ++j) {
            const int rel = kt * 16 + d0 + j;
            float s;
            if (kt == 0) s = (rel >= 0) ? sc[kt][j] + bl[max(j, -d0)] : -1e30f;
            else if (kt == 16) s = (rel <= 256) ? sc[kt][j] + bl[min(256 + j, 256 - d0)] : -1e30f;
            else s = sc[kt][j] + bl[kt * 16 + j];
            sc[kt][j] = s;
            mx = fmaxf(mx, s);
          }
        }
      } else {
#pragma unroll
        for (int kt = 0; kt < 17; ++kt) {
#pragma unroll
          for (int j = 0; j < 4; ++j) {
            const int r = (qt + kt) * 16 + 4 * fq + j, rel = r - i, kp = q0 - 128 + r;
            const bool valid = (rel >= 0) && (rel <= 256) && (kp >= 0) && (kp < S);
            const float s = valid ? sc[kt][j] + bias_s[gq * 257 + min(max(rel, 0), 256)] : -1e30f;
            sc[kt][j] = s;
            mx = fmaxf(mx, s);
          }
        }
      }
      mx = fmaxf(mx, __shfl_xor(mx, 16, 64));
      mx = fmaxf(mx, __shfl_xor(mx, 32, 64));
      float sum = 0.f;
#pragma unroll
      for (int kt = 0; kt < 17; ++kt) {
#pragma unroll
        for (int j = 0; j < 4; ++j) { float pe = __expf(sc[kt][j] - mx); sc[kt][j] = pe; sum += pe; }
      }
      sum += __shfl_xor(sum, 16, 64);
      sum += __shfl_xor(sum, 32, 64);
      sum += __expf(sinkv - mx);
      const float inv = 1.f / sum;
      h16x8 pb[9];
#pragma unroll
      for (int u = 0; u < 9; ++u) {
#pragma unroll
        for (int j = 0; j < 4; ++j) { pb[u][j] = (h16)sc[2 * u][j]; pb[u][4 + j] = (h16)sc[2 * u + 1][j]; }
      }
#pragma unroll
      for (int dt = 0; dt < 4; ++dt) {
        f32x4 acc = {0.f, 0.f, 0.f, 0.f};
        const h16* vr = VT + (dt * 16 + fr) * KP + qt * 16 + 4 * fq;
#pragma unroll
        for (int u = 0; u < 9; ++u) {
          h16x4 va = *(const h16x4*)(vr + u * 32), vb = *(const h16x4*)(vr + u * 32 + 16);
          h16x8 a = {va[0], va[1], va[2], va[3], vb[0], vb[1], vb[2], vb[3]};
          acc = __builtin_amdgcn_mfma_f32_16x16x32_f16(a, pb[u], acc, 0, 0, 0);
        }
        h16x4 ov = {(h16)(acc[0] * inv), (h16)(acc[1] * inv), (h16)(acc[2] * inv), (h16)(acc[3] * inv)};
        if (!dry) *(h16x4*)(qrow + dt * 16 + 4 * fq) = ov;
      }
    }
    __syncthreads();
  }
}

__device__ void phase_gmlp(const Params& p, int l, char* shm, int dry) {
  CTX;
  constexpr int GP = 136;
  h16* vnT = (h16*)shm;
  h16* Ws = vnT + 128 * GP;
  float* mean_s = (float*)(Ws + 128 * GP);
  float* rstd_s = mean_s + 128;
  const int wid = TIDX >> 6, lane = TIDX & 63, fr = lane & 15, fq = lane >> 4;
  const float* lng = p.gmlp_ln_g + l * 512;
  const float* lnb = p.gmlp_ln_b + l * 512;
  const int nitems = (TG / 128) * 2;
  for (int item = BIDX; item < nitems; item += gridDim.x) {
    const int half = item & 1, t0 = (item >> 1) * 128;
    const int row = TIDX >> 2, part = TIDX & 3;
    const h16* rp = p.proj + (size_t)(t0 + row) * LDP + CGV;
    {
      float sum = 0.f, sq = 0.f;
#pragma unroll
      for (int c = 0; c < 128; c += 8) {
        h16x8 v = *(const h16x8*)(rp + part * 128 + c);
#pragma unroll
        for (int j = 0; j < 8; ++j) { float ge = gelu_t((float)v[j]); sum += ge; sq += ge * ge; }
      }
      sum += __shfl_xor(sum, 1, 64); sum += __shfl_xor(sum, 2, 64);
      sq += __shfl_xor(sq, 1, 64); sq += __shfl_xor(sq, 2, 64);
      float mean = sum * (1.f / 512.f);
      float var = fmaxf(sq * (1.f / 512.f) - mean * mean, 0.f);
      if (part == 0) { mean_s[row] = mean; rstd_s[row] = rsqrtf(var + EPS); }
    }
#pragma unroll 1
    for (int gi = 0; gi < 2; ++gi) {
      const int grp = half * 2 + gi;
      __syncthreads();
      {
        const float mean = mean_s[row], rstd = rstd_s[row];
#pragma unroll
        for (int c = 0; c < 32; c += 8) {
          int cl = part * 32 + c;
          h16x8 v = *(const h16x8*)(rp + grp * 128 + cl);
#pragma unroll
          for (int j = 0; j < 8; ++j) {
            float ge = gelu_t((float)v[j]);
            vnT[(cl + j) * GP + row] = (h16)((ge - mean) * rstd * lng[grp * 128 + cl + j] + lnb[grp * 128 + cl + j]);
          }
        }
        const h16* w = p.wt + (size_t)l * WL + O_WSP + grp * 16384;
#pragma unroll
        for (int k = 0; k < 4; ++k) {
          int e = (TIDX + k * 512) * 8, tt = e >> 7, s0 = e & 127;
          *(h16x8*)(Ws + tt * GP + s0) = *(const h16x8*)(w + e);
        }
      }
      __syncthreads();
      const int t = wid * 16 + fr;
      h16x8 bfrag[4];
#pragma unroll
      for (int ks = 0; ks < 4; ++ks) bfrag[ks] = *(const h16x8*)(Ws + t * GP + ks * 32 + fq * 8);
      const float bsv = p.b_spatial[(size_t)l * 512 + grp * 128 + t];
      h16* ubase = p.proj + (size_t)(t0 + t) * LDP + CGU + grp * 128 + 4 * fq;
      h16x4 uvs[8];
#pragma unroll
      for (int et = 0; et < 8; ++et) uvs[et] = *(const h16x4*)(ubase + et * 16);
#pragma unroll
      for (int et = 0; et < 8; ++et) {
        f32x4 acc = {0.f, 0.f, 0.f, 0.f};
#pragma unroll
        for (int ks = 0; ks < 4; ++ks)
          acc = __builtin_amdgcn_mfma_f32_16x16x32_f16(*(const h16x8*)(vnT + (et * 16 + fr) * GP + ks * 32 + fq * 8), bfrag[ks], acc, 0, 0, 0);
        h16* up = ubase + et * 16;
        h16x4 uv = uvs[et], ov;
#pragma unroll
        for (int j = 0; j < 4; ++j) ov[j] = (h16)(gelu_t((float)uv[j]) * (acc[j] + bsv));
        if (!dry) *(h16x4*)up = ov;
      }
    }
    __syncthreads();
  }
}

constexpr int SP = 136;

#define CT_S(k, LOG) ((TIDX + (k)*512) >> (LOG))
#define CT_C8(k, LOG) (((TIDX + (k)*512) & ((1 << (LOG)) - 1)) * 8)
#define XROW(s) (p.proj + (size_t)(t0 + (s)) * LDP + CX)
#define HP(s) (tl0 + (s) > 0)
#define HN(s) (tl0 + (s) < S - 1)
__device__ __forceinline__ int swz_off(int row, int col) { return row * SP + ((((col >> 3) ^ ((row >> 3) & 7)) << 3) | (col & 7)); }
struct Raw3 { h16x8 p, c, n; };
__device__ __forceinline__ Raw3 conv_load(const h16* rp, bool hp, bool hn) {
  const h16x8 zero = {0, 0, 0, 0, 0, 0, 0, 0};
  Raw3 r;
  r.c = *(const h16x8*)rp;
  r.p = *(const h16x8*)(hp ? rp - LDP : rp);
  r.n = *(const h16x8*)(hn ? rp + LDP : rp);
  r.p = hp ? r.p : zero;
  r.n = hn ? r.n : zero;
  return r;
}
__device__ __forceinline__ void conv_apply(const Raw3& r, const float4* __restrict__ cwS, float (&o)[8]) {
#pragma unroll
  for (int j = 0; j < 8; ++j) {
    const float4 w = cwS[j];
    float v = w.w + (float)r.p[j] * w.x + (float)r.c[j] * w.y + (float)r.n[j] * w.z;
    o[j] = silu_f(v);
  }
}
__device__ __forceinline__ void ssd_dt_cum(const Params& p, int l, int t0, int grp, float* dts, float* cums, int TIDX) {
#pragma unroll
  for (int i = TIDX; i < 2048; i += 512) {
    int tok = i >> 4, j = i & 15, col = (j >> 3) * 16 + grp * 8 + (j & 7);
    float v = p.dtbuf[(size_t)(t0 + tok) * 32 + col] + p.dt_bias[l * 32 + col];
    dts[j * 128 + tok] = (v > 20.f) ? v : log1pf(expf(v));
  }
  __syncthreads();
  const int wid = TIDX >> 6, lane = TIDX & 63;
#pragma unroll
  for (int k = 0; k < 2; ++k) {
    const int combo = wid * 2 + k, dir = combo >> 3;
    const float a = -expf(p.a_log[l * 32 + dir * 16 + grp * 8 + (combo & 7)]);
    const int e0 = lane * 2;
    const int ta = dir ? 127 - e0 : e0, tb = dir ? 126 - e0 : e0 + 1;
    float v0 = dts[combo * 128 + ta] * a, v1 = dts[combo * 128 + tb] * a;
    float s = v0 + v1;
#pragma unroll
    for (int o = 1; o < 64; o <<= 1) {
      float n = __shfl_up(s, o, 64);
      if (lane >= o) s += n;
    }
    cums[combo * 128 + tb] = s;
    cums[combo * 128 + ta] = s - v1;
  }
  __syncthreads();
}

__device__ void phase_ssd_state(const Params& p, int g, int l, char* shm) {
  CTX;
  const int S = (g < 2) ? 2048 : 8192;
  h16* BT = (h16*)shm;
  h16* XT = BT + 128 * SP;
  float* dts = (float*)(XT + 64 * SP);
  float* cums = dts + 2048;
  h16* wv = (h16*)(cums + 2048);
  float4* cwS = (float4*)(wv + 2048);
  const int wid = TIDX >> 6, lane = TIDX & 63, fr = lane & 15, fq = lane >> 4;
  const float* cw = p.conv_w + (size_t)l * 4608;
  const float* cb = p.conv_b + (size_t)l * 1536;
  for (int item = BIDX; item < 256; item += gridDim.x) {
    const int grp = item & 1, ch = item >> 1, t0 = ch * 128, tl0 = t0 & (S - 1);
#pragma unroll
    for (int i = TIDX; i < 640; i += 512) {
      int c = (i < 128) ? 1024 + grp * 128 + i : grp * 512 + (i - 128);
      cwS[i] = float4{cw[c], cw[1536 + c], cw[3072 + c], cb[c]};
    }
    Raw3 br[4];
#pragma unroll
    for (int k = 0; k < 4; ++k) { const int s = CT_S(k, 4); br[k] = conv_load(XROW(s) + 1024 + grp * 128 + CT_C8(k, 4), HP(s), HN(s)); }
    Raw3 xr[2];
#pragma unroll
    for (int k = 0; k < 2; ++k) { const int s = CT_S(k, 3); xr[k] = conv_load(XROW(s) + grp * 512 + CT_C8(k, 3), HP(s), HN(s)); }
    ssd_dt_cum(p, l, t0, grp, dts, cums, TIDX);
#pragma unroll
    for (int i = TIDX; i < 2048; i += 512) {
      int combo = i >> 7;
      float cend = cums[combo * 128 + ((combo >> 3) ? 0 : 127)];
      wv[i] = (h16)(__expf(cend - cums[i]) * dts[i]);
    }
    if (TIDX < 16) p.dec[(ch * 2 + grp) * 16 + TIDX] = __expf(cums[TIDX * 128 + ((TIDX >> 3) ? 0 : 127)]);
#pragma unroll
    for (int k = 0; k < 4; ++k) {
      float o[8];
      const int s = CT_S(k, 4), c8 = CT_C8(k, 4);
      conv_apply(br[k], cwS + c8, o);
#pragma unroll
      for (int j = 0; j < 8; ++j) BT[swz_off(c8 + j, s)] = (h16)o[j];
    }
    __syncthreads();
    h16x8 af[4];
#pragma unroll
    for (int ks = 0; ks < 4; ++ks) af[ks] = *(const h16x8*)(BT + swz_off(wid * 16 + fr, ks * 32 + fq * 8));
#pragma unroll 1
    for (int hh = 0; hh < 8; ++hh) {
      __syncthreads();
#pragma unroll
      for (int k = 0; k < 2; ++k) {
        float o[8];
        const int s = CT_S(k, 3), c8 = CT_C8(k, 3);
        conv_apply(xr[k], cwS + 128 + hh * 64 + c8, o);
#pragma unroll
        for (int j = 0; j < 8; ++j) XT[swz_off(c8 + j, s)] = (h16)o[j];
      }
      if (hh < 7) {
#pragma unroll
        for (int k = 0; k < 2; ++k) { const int s = CT_S(k, 3); xr[k] = conv_load(XROW(s) + grp * 512 + (hh + 1) * 64 + CT_C8(k, 3), HP(s), HN(s)); }
      }
      __syncthreads();
#pragma unroll
      for (int dir = 0; dir < 2; ++dir) {
        const int combo = dir * 8 + hh;
        h16* stp = p.st + ((((size_t)ch * 2 + grp) * 2 + dir) * 8 + hh) * 8192;
#pragma unroll
        for (int pt = 0; pt < 4; ++pt) {
          f32x4 acc = {0.f, 0.f, 0.f, 0.f};
#pragma unroll
          for (int ks = 0; ks < 4; ++ks) {
            h16x8 xb = *(const h16x8*)(XT + swz_off(pt * 16 + fr, ks * 32 + fq * 8)) * *(const h16x8*)(wv + combo * 128 + ks * 32 + fq * 8);
            acc = __builtin_amdgcn_mfma_f32_16x16x32_f16(af[ks], xb, acc, 0, 0, 0);
          }
          h16x4 o4 = {(h16)acc[0], (h16)acc[1], (h16)acc[2], (h16)acc[3]};
          *(h16x4*)(stp + (pt * 16 + fr) * 128 + wid * 16 + 4 * fq) = o4;
        }
      }
    }
    __syncthreads();
  }
}

template <int W>
__device__ __forceinline__ void ssd_scan_body(const Params& p, int g, int dry, int TIDX, int BIDX) {
  typedef _Float16 hv __attribute__((ext_vector_type(W)));
  const int S = (g < 2) ? 2048 : 8192, nc = S / 128, nseq = TG / S;
  constexpr int VPC = 8192 / W;
  const int total = nseq * 32 * VPC;
  for (int idx = BIDX * 512 + TIDX; idx < total; idx += gridDim.x * 512) {
    const int v = idx % VPC, combo = (idx / VPC) & 31, seq = idx / (VPC * 32), dir = (combo >> 3) & 1;
    float carry[W];
#pragma unroll
    for (int j = 0; j < W; ++j) carry[j] = 0.f;
    for (int i = 0; i < nc; i += 8) {
      hv L[8]; float d[8]; h16* ptr[8];
#pragma unroll
      for (int u = 0; u < 8; ++u) {
        int c = dir ? nc - 1 - (i + u) : (i + u);
        int chg = seq * nc + c;
        ptr[u] = p.st + ((size_t)chg * 32 + combo) * 8192 + v * W;
        L[u] = *(const hv*)ptr[u];
        d[u] = p.dec[chg * 32 + combo];
      }
#pragma unroll
      for (int u = 0; u < 8; ++u) {
        hv o;
#pragma unroll
        for (int j = 0; j < W; ++j) { o[j] = (h16)carry[j]; carry[j] = carry[j] * d[u] + (float)L[u][j]; }
        if (!dry) *(hv*)ptr[u] = o;
      }
    }
  }
}
__device__ void phase_ssd_scan(const Params& p, int g, int dry) {
  CTX;
  if (g < 2) ssd_scan_body<8>(p, g, dry, TIDX, BIDX);
  else ssd_scan_body<4>(p, g, dry, TIDX, BIDX);
}

__device__ void phase_ssd_out(const Params& p, int g, int l, char* shm, int dry) {
  CTX;
  const int S = (g < 2) ? 2048 : 8192;
  h16* Cs = (h16*)shm;
  h16* Bs = Cs + 128 * SP;
  h16* Sf = Bs;
  h16* Sb = Bs + 64 * SP;
  h16* XT = Bs + 128 * SP;
  h16* Ms = XT + 64 * SP;
  float* dts = (float*)(Ms + 128 * SP);
  float* cums = dts + 2048;
  float4* cwS = (float4*)(cums + 2048);
  const int wid = TIDX >> 6, lane = TIDX & 63, fr = lane & 15, fq = lane >> 4;
  const float* cw = p.conv_w + (size_t)l * 4608;
  const float* cb = p.conv_b + (size_t)l * 1536;
  for (int item = BIDX; item < 256; item += gridDim.x) {
    const int grp = item & 1, ch = item >> 1, t0 = ch * 128, tl0 = t0 & (S - 1);
#pragma unroll
    for (int i = TIDX; i < 768; i += 512) {
      int c = (i < 128) ? 1024 + grp * 128 + i : (i < 256) ? 1280 + grp * 128 + (i - 128) : grp * 512 + (i - 256);
      cwS[i] = float4{cw[c], cw[1536 + c], cw[3072 + c], cb[c]};
    }
    Raw3 br[4];
#pragma unroll
    for (int k = 0; k < 4; ++k) { const int s = CT_S(k, 4); br[k] = conv_load(XROW(s) + 1024 + grp * 128 + CT_C8(k, 4), HP(s), HN(s)); }
    ssd_dt_cum(p, l, t0, grp, dts, cums, TIDX);
#pragma unroll
    for (int k = 0; k < 4; ++k) {
      float o[8];
      const int s = CT_S(k, 4), c8 = CT_C8(k, 4);
      conv_apply(br[k], cwS + c8, o);
      h16x8 ov;
#pragma unroll
      for (int j = 0; j < 8; ++j) ov[j] = (h16)o[j];
      *(h16x8*)(Bs + s * SP + c8) = ov;
    }
#pragma unroll
    for (int k = 0; k < 4; ++k) { const int s = CT_S(k, 4); br[k] = conv_load(XROW(s) + 1280 + grp * 128 + CT_C8(k, 4), HP(s), HN(s)); }
    Raw3 xr[2];
#pragma unroll
    for (int k = 0; k < 2; ++k) { const int s = CT_S(k, 3); xr[k] = conv_load(XROW(s) + grp * 512 + CT_C8(k, 3), HP(s), HN(s)); }
    const int sc8 = (TIDX & 15) * 8;
    const h16* stb = p.st + (((size_t)ch * 2 + grp) * 2) * 8 * 8192;
#pragma unroll
    for (int k = 0; k < 4; ++k) {
      float o[8];
      const int s = CT_S(k, 4), c8 = CT_C8(k, 4);
      conv_apply(br[k], cwS + 128 + c8, o);
      h16x8 ov;
#pragma unroll
      for (int j = 0; j < 8; ++j) ov[j] = (h16)o[j];
      *(h16x8*)(Cs + s * SP + c8) = ov;
    }
    __syncthreads();
    const int lcol = wid * 16 + fr;
    f32x4 cbT[8];
#pragma unroll
    for (int st = 0; st < 8; ++st) {
      f32x4 acc = {0.f, 0.f, 0.f, 0.f};
#pragma unroll
      for (int ks = 0; ks < 4; ++ks) {
        h16x8 a = *(const h16x8*)(Bs + (st * 16 + fr) * SP + ks * 32 + fq * 8);
        acc = __builtin_amdgcn_mfma_f32_16x16x32_f16(a, *(const h16x8*)(Cs + lcol * SP + ks * 32 + fq * 8), acc, 0, 0, 0);
      }
      cbT[st] = acc;
    }
    float ssq_acc = 0.f;
    h16* zrow = p.proj + (size_t)(t0 + lcol) * LDP + CZ + grp * 512 + 4 * fq;
#pragma unroll 1
    for (int hh = 0; hh < 8; ++hh) {
      __syncthreads();
      h16x8 sfr[4];
#pragma unroll
      for (int k = 0; k < 4; ++k) {
        int task = TIDX + k * 512, which = task >> 10, r = (task >> 4) & 63;
        sfr[k] = *(const h16x8*)(stb + ((size_t)which * 8 + hh) * 8192 + r * 128 + sc8);
      }
#pragma unroll
      for (int k = 0; k < 2; ++k) {
        float o[8];
        const int s = CT_S(k, 3), c8 = CT_C8(k, 3);
        conv_apply(xr[k], cwS + 256 + hh * 64 + c8, o);
#pragma unroll
        for (int j = 0; j < 8; ++j) XT[swz_off(c8 + j, s)] = (h16)o[j];
      }
      if (hh < 7) {
#pragma unroll
        for (int k = 0; k < 2; ++k) { const int s = CT_S(k, 3); xr[k] = conv_load(XROW(s) + grp * 512 + (hh + 1) * 64 + CT_C8(k, 3), HP(s), HN(s)); }
      }
      const float cfl = cums[hh * 128 + lcol], cbl = cums[(8 + hh) * 128 + lcol];
#pragma unroll
      for (int st = 0; st < 8; ++st) {
        const int s0 = st * 16 + 4 * fq;
        f32x4 cfs = *(const f32x4*)(cums + hh * 128 + s0), cbs = *(const f32x4*)(cums + (8 + hh) * 128 + s0);
        f32x4 dfs = *(const f32x4*)(dts + hh * 128 + s0), dbs = *(const f32x4*)(dts + (8 + hh) * 128 + s0);
        h16x4 mv;
#pragma unroll
        for (int j = 0; j < 4; ++j) {
          const int s = s0 + j;
          float e = (s <= lcol) ? cfl - cfs[j] : cbl - cbs[j];
          float d = (s <= lcol) ? dfs[j] : dbs[j];
          float v = __expf(e) * d;
          if (s == lcol) v = dfs[j] + dbs[j];
          mv[j] = (h16)(cbT[st][j] * v);
        }
        *(h16x4*)(Ms + lcol * SP + s0) = mv;
      }
#pragma unroll
      for (int k = 0; k < 4; ++k) {
        int task = TIDX + k * 512, which = task >> 10, r = (task >> 4) & 63;
        *(h16x8*)((which ? Sb : Sf) + r * SP + sc8) = sfr[k];
      }
      __syncthreads();
      h16x4 zv[4];
#pragma unroll
      for (int pt = 0; pt < 4; ++pt) zv[pt] = *(const h16x4*)(zrow + hh * 64 + pt * 16);
      h16x8 mfrag[4];
#pragma unroll
      for (int ks = 0; ks < 4; ++ks) mfrag[ks] = *(const h16x8*)(Ms + lcol * SP + ks * 32 + fq * 8);
      const float ecf = __expf(cfl), ecb = __expf(cbl), Dk = p.d_skip[l * 16 + grp * 8 + hh];
#pragma unroll
      for (int pt = 0; pt < 4; ++pt) {
        f32x4 aY = {0.f, 0.f, 0.f, 0.f}, aF = aY, aB = aY;
#pragma unroll
        for (int ks = 0; ks < 4; ++ks) {
          const int o = (pt * 16 + fr) * SP + ks * 32 + fq * 8;
          aY = __builtin_amdgcn_mfma_f32_16x16x32_f16(*(const h16x8*)(XT + swz_off(pt * 16 + fr, ks * 32 + fq * 8)), mfrag[ks], aY, 0, 0, 0);
          const h16x8 cf = *(const h16x8*)(Cs + lcol * SP + ks * 32 + fq * 8);
          aF = __builtin_amdgcn_mfma_f32_16x16x32_f16(*(const h16x8*)(Sf + o), cf, aF, 0, 0, 0);
          aB = __builtin_amdgcn_mfma_f32_16x16x32_f16(*(const h16x8*)(Sb + o), cf, aB, 0, 0, 0);
        }
        const int p0 = pt * 16 + 4 * fq;
        h16x4 ov;
#pragma unroll
        for (int j = 0; j < 4; ++j) {
          float x = (float)XT[swz_off(p0 + j, lcol)];
          float y = aY[j] + ecf * aF[j] + ecb * aB[j] + Dk * x;
          float gt = y * silu_f((float)zv[pt][j]);
          ssq_acc += gt * gt;
          ov[j] = (h16)gt;
        }
        if (!dry) *(h16x4*)(zrow + hh * 64 + pt * 16) = ov;
      }
    }
    ssq_acc += __shfl_xor(ssq_acc, 16, 64);
    ssq_acc += __shfl_xor(ssq_acc, 32, 64);
    if (fq == 0 && !dry) p.ssq[(size_t)(t0 + lcol) * 2 + grp] = ssq_acc;
    __syncthreads();
  }
}

#define XB_TMO 128
#define XB_XCNT(j) (256 + 64 * (j))
#define XB_XSUB(j) (1280 + 64 * (j))
#define XB_XGEN(j) (2304 + 64 * (j))
#define XB_TOP 3328
#define XB_TOPGEN 3392
#define XCD_BAR_WORDS 3456
#define XB_SPIN_CAP (1u << 20)
__device__ __forceinline__ unsigned xb_ld(unsigned* p) { return __hip_atomic_load(p, __ATOMIC_RELAXED, __HIP_MEMORY_SCOPE_AGENT); }
__device__ __forceinline__ unsigned xb_add(unsigned* p, unsigned v) { return __hip_atomic_fetch_add(p, v, __ATOMIC_RELAXED, __HIP_MEMORY_SCOPE_AGENT); }
__device__ __forceinline__ unsigned xb_xcc_id() { return (unsigned)__builtin_amdgcn_s_getreg((3 << 11) | 20) & 0xFu; }
#define XB_SPIN(cond, bar)                                                                        \
  do {                                                                                            \
    unsigned _sp = 0;                                                                             \
    while (cond) {                                                                                \
      __builtin_amdgcn_s_sleep(1);                                                                \
      if ((++_sp & 255u) == 0u) {                                                                 \
        if (xb_ld(&(bar)[XB_TMO])) break;                                                         \
        if (_sp > XB_SPIN_CAP) { atomicAdd(&(bar)[XB_TMO], 1u); break; }                          \
      }                                                                                           \
    }                                                                                             \
  } while (0)
__device__ __forceinline__ void xcd_barrier_complete(unsigned* bar, unsigned x, unsigned& nloc, unsigned& nx) {
  const unsigned G = gridDim.x;
  unsigned sum, cnt, mine, sp = 0u;
  for (;;) {
    sum = 0u; cnt = 0u; mine = 0u;
#pragma unroll
    for (unsigned j = 0; j < 16; ++j) { const unsigned c = xb_ld(&bar[XB_XCNT(j)]); sum += c; cnt += (c > 0u) ? 1u : 0u; mine = (j == x) ? c : mine; }
    if (sum == G) break;
    __builtin_amdgcn_s_sleep(1);
    if ((++sp & 255u) == 0u) { if (xb_ld(&bar[XB_TMO])) break; if (sp > XB_SPIN_CAP) { atomicAdd(&bar[XB_TMO], 1u); break; } }
  }
  nloc = mine > 0u ? mine : 1u; nx = cnt > 0u ? cnt : 1u;
}
__device__ __forceinline__ void xcd_barrier(unsigned* bar, unsigned x, volatile LAS unsigned* st) {
  asm volatile("s_waitcnt vmcnt(0)" ::: "memory");
  __syncthreads();
  if (threadIdx.x == 0) {
    __builtin_amdgcn_s_waitcnt(0);
    unsigned nloc = st[0], nx = st[1];
    if (nloc == 0u) { xcd_barrier_complete(bar, x, nloc, nx); st[0] = nloc; st[1] = nx; }
    const unsigned old = xb_add(&bar[XB_XSUB(x)], 1u);
    const unsigned gen = old / nloc;
    if (old + 1u == (gen + 1u) * nloc) {
      __builtin_amdgcn_fence(__ATOMIC_RELEASE, "agent");
      asm volatile("s_waitcnt vmcnt(0)" ::: "memory");
      const unsigned og = xb_add(&bar[XB_TOP], 1u);
      const unsigned tg = og / nx;
      if (og + 1u == (tg + 1u) * nx) xb_add(&bar[XB_TOPGEN], 1u);
      else XB_SPIN(xb_ld(&bar[XB_TOPGEN]) == tg, bar);
      __builtin_amdgcn_fence(__ATOMIC_ACQUIRE, "agent");
      xb_add(&bar[XB_XGEN(x)], 1u);
      asm volatile("s_waitcnt vmcnt(0)" ::: "memory");
    } else {
      XB_SPIN(xb_ld(&bar[XB_XGEN(x)]) == gen, bar);
      __builtin_amdgcn_fence(__ATOMIC_ACQUIRE, "agent");
      asm volatile("s_waitcnt vmcnt(0)" ::: "memory");
    }
  }
  __syncthreads();
}

__device__ __forceinline__ unsigned long long rd_tab(const unsigned* tab, int i) {
  unsigned lo = __builtin_amdgcn_readfirstlane(tab[2 * i]), hi = __builtin_amdgcn_readfirstlane(tab[2 * i + 1]);
  return ((unsigned long long)hi << 32) | lo;
}
template <class T> __device__ __forceinline__ T* as_global(unsigned long long v) {
  return (T*)(__attribute__((address_space(1))) T*)v;
}
__device__ __forceinline__ Params load_params(const unsigned* tab) {
  Params q;
#define X(i, T, n) q.n = as_global<std::remove_pointer_t<T>>(rd_tab(tab, i));
  PFIELDS(X)
#undef X
  q.step_lo = 0; q.step_hi = 0;
  return q;
}
#define LP const Params p = load_params(tab)
__device__ void run_step(const unsigned* tab, int s, char* shm) {
  if (s == 0) { { LP; phase_prep(p, shm); } { LP; phase_pre(p, 0); } return; }
  s -= 1;
  const int g = s >> 5, r = s & 31;
  const int l = r >> 3, ph = r & 7;
  switch (ph) {
    case 0: { LP; phase_inproj(p, l, shm); } break;
    case 1:
      if (blockIdx.x & 1) { { LP; phase_gmlp(p, l, shm, 0); } { LP; phase_ssd_state(p, g, l, shm); } }
      else { { LP; phase_ssd_state(p, g, l, shm); } { LP; phase_gmlp(p, l, shm, 0); } }
      break;
    case 2:
      if (blockIdx.x & 1) { { LP; phase_attn(p, g, l, shm, 0); } { LP; phase_ssd_scan(p, g, 0); } }
      else { { LP; phase_ssd_scan(p, g, 0); } { LP; phase_attn(p, g, l, shm, 0); } }
      break;
    case 3: { LP; phase_ssd_out(p, g, l, shm, 0); } break;
    case 4: { LP; phase_merge(p, l, shm); } break;
    case 5: { LP; phase_wout(p, g, l, shm); } break;
    case 6: { LP; phase_ff1(p, l, shm); } break;
    default: { { LP; phase_ff2(p, g, l, shm); } if (l == NLAYER - 1 && g < 2) { LP; phase_pre(p, g + 1); } } break;
  }
}

__global__ void __launch_bounds__(512, 2) mega(Params p) {
  extern __shared__ __attribute__((aligned(16))) char shm[];
  unsigned long long* tab = (unsigned long long*)(shm + SHM_TAB);
  volatile LAS unsigned* bst = (volatile LAS unsigned*)(LAS unsigned*)(shm + SHM_TAB - 16);
  if (threadIdx.x == 0) {
#define X(i, T, n) tab[i] = (unsigned long long)p.n;
    PFIELDS(X)
#undef X
    bst[0] = 0u; bst[1] = 0u;
  }
  const int lo = p.step_lo, hi = p.step_hi;
  unsigned* bar = p.bar;
  const unsigned xcc = xb_xcc_id();
  __syncthreads();
  if (threadIdx.x == 0) (void)xb_add(&bar[XB_XCNT(xcc)], 1u);
  for (int s = lo; s < hi; ++s) {
    if (s > lo) {
      if (s == lo + 1) cg::this_grid().sync();
      else xcd_barrier(as_global<unsigned>(rd_tab((const unsigned*)tab, 36)), xcc, bst);
    }
    run_step((const unsigned*)tab, s, shm);
  }
}

extern "C" void kernel_launch(void* const* d_in, const int* in_sizes, int n_in, void* d_out, int out_size, void* d_ws,
                              size_t ws_size, hipStream_t stream) {
  Params p{};
  {
    const float** fp = (const float**)&p;
    for (int i = 0; i < 25; ++i) fp[i] = (const float*)d_in[i];
  }
  p.out = (float*)d_out;
  char* ws = (char*)d_ws;
  size_t off = 0;
  p.wt = (h16*)(ws + off); off += (size_t)NLAYER * WL * 2;
  p.proj = (h16*)(ws + off); off += (size_t)TG * LDP * 2;
  p.bufA = (h16*)(ws + off); off += (size_t)TG * 1024 * 2;
  p.bufB = (h16*)(ws + off); off += (size_t)TG * 1024 * 2;
  p.st = (h16*)(ws + off); off += (size_t)64 << 20;
  p.rssX = (float*)(ws + off); off += (size_t)TG * 4;
  p.rssH = (float*)(ws + off); off += (size_t)TG * 4;
  p.dtbuf = (float*)(ws + off); off += (size_t)TG * 32 * 4;
  p.dec = (float*)(ws + off); off += (size_t)128 * 32 * 4;
  p.ssq = (float*)(ws + off); off += (size_t)TG * 2 * 4;
  p.bar = (unsigned*)(ws + off); off += (size_t)XCD_BAR_WORDS * 4;
  static int grid_blocks = 0;
  if (!grid_blocks) {
    (void)hipFuncSetAttribute((const void*)mega, hipFuncAttributeMaxDynamicSharedMemorySize, SHM_TOTAL);
    int dev = 0, cus = 0, per_cu = 0;
    (void)hipGetDevice(&dev);
    (void)hipDeviceGetAttribute(&cus, hipDeviceAttributeMultiprocessorCount, dev);
    (void)hipOccupancyMaxActiveBlocksPerMultiprocessor(&per_cu, mega, 512, SHM_TOTAL);
    grid_blocks = cus * per_cu;
    if (grid_blocks > 256 || grid_blocks <= 0) grid_blocks = 256;
  }
  (void)hipMemsetAsync(p.bar, 0, (size_t)XCD_BAR_WORDS * 4, stream);
#if MULTI_LAUNCH
  for (int s = 0; s < NSTEPS; ++s) {
    p.step_lo = s;
    p.step_hi = s + 1;
    hipLaunchKernelGGL(mega, dim3(grid_blocks), dim3(512), SHM_TOTAL, stream, p);
  }
#else
  p.step_lo = 0;
  p.step_hi = NSTEPS;
  void* args[] = {&p};
  (void)hipLaunchCooperativeKernel((void*)mega, dim3(grid_blocks), dim3(512), args, SHM_TOTAL, stream);
#endif
}
```

```cpp
#include <hip/hip_runtime.h>
#include <hip/hip_fp16.h>
#include <hip/hip_cooperative_groups.h>
#include <type_traits>
namespace cg = cooperative_groups;

#ifndef MULTI_LAUNCH
#define MULTI_LAUNCH 0
#endif

typedef _Float16 h16;
using h16x8 = __attribute__((ext_vector_type(8))) _Float16;
using h16x4 = __attribute__((ext_vector_type(4))) _Float16;
using h16x2 = __attribute__((ext_vector_type(2))) _Float16;
using f32x4 = __attribute__((ext_vector_type(4))) float;

constexpr int LDP = 7456, TG = 16384, NLAYER = 4, LDH = 4160;
constexpr int CQ = 0, CK = 512, CV = 640, CGU = 768, CGV = 1280, CZ = 1792, CX = 2816, CDT = 4352, CG = 4384;
constexpr float EPS = 1e-6f;
constexpr long O_WIN = 0, O_UPA = 7456L * 1024, O_UPB = O_UPA + 524288, O_UPC = O_UPB + 524288, O_WOUT = O_UPC + 1048576,
               O_FF1 = O_WOUT + 1048576, O_FF2 = O_FF1 + 4194304, O_WSP = O_FF2 + 1024L * LDH, WL = O_WSP + 65536;
constexpr int SHM_GEMM = 131072, SHM_TOTAL = 163840, SHM_TAB = 162816;
constexpr int NSTEPS = 1 + 3 * 32;

#define PFIELDS(X)                                                                                                         \
  X(0, const float*, x_prompt) X(1, const float*, x_sample) X(2, const float*, rel_bias) X(3, const float*, norm_mix_g)    \
  X(4, const float*, w_in) X(5, const float*, q_norm_g) X(6, const float*, k_norm_g) X(7, const float*, attn_sink)         \
  X(8, const float*, gmlp_ln_g) X(9, const float*, gmlp_ln_b) X(10, const float*, w_spatial) X(11, const float*, b_spatial) \
  X(12, const float*, conv_w) X(13, const float*, conv_b) X(14, const float*, dt_bias) X(15, const float*, a_log)          \
  X(16, const float*, d_skip) X(17, const float*, ssd_norm_g) X(18, const float*, w_up_attn) X(19, const float*, w_up_gmlp) \
  X(20, const float*, w_up_ssd) X(21, const float*, w_out) X(22, const float*, norm_ff_g) X(23, const float*, w_ff1)       \
  X(24, const float*, w_ff2) X(25, float*, out) X(26, h16*, wt) X(27, h16*, proj) X(28, h16*, bufA) X(29, h16*, bufB)      \
  X(30, h16*, st) X(31, float*, rssX) X(32, float*, rssH) X(33, float*, dtbuf) X(34, float*, dec) X(35, float*, ssq) X(36, unsigned*, bar)
struct Params {
#define X(i, T, n) T n;
  PFIELDS(X)
#undef X
  int step_lo, step_hi;
};

__device__ __forceinline__ float wave_sum(float v) {
#pragma unroll
  for (int o = 32; o > 0; o >>= 1) v += __shfl_xor(v, o, 64);
  return v;
}
__device__ __forceinline__ float gelu_t(float x) {
  float u2 = 1.5957691216057308f * (x + 0.044715f * x * x * x);
  return x * __builtin_amdgcn_rcpf(1.f + __expf(-u2));
}
__device__ __forceinline__ float silu_f(float x) { return x * __builtin_amdgcn_rcpf(1.f + __expf(-x)); }
__device__ __forceinline__ float clampf(float x, float lo, float hi) { return fminf(fmaxf(x, lo), hi); }

__device__ __forceinline__ int opaque_tid() { int t = threadIdx.x; asm volatile("" : "+v"(t)); return t; }
__device__ __forceinline__ int opaque_bid() { int b = blockIdx.x; asm volatile("" : "+s"(b)); return b; }
#define CTX const int TIDX = opaque_tid(); const int BIDX = opaque_bid(); (void)TIDX; (void)BIDX

__device__ void prep_tile(const float* __restrict__ src, int K, int N, h16* __restrict__ dst, const float* __restrict__ scale,
                          int nt, int kt, char* shm, int ldd = 0) {
  CTX;
  float(*tile)[65] = (float(*)[65])shm;
  const int tid = TIDX;
  const int n0 = nt * 64, k0 = kt * 64;
  {
    int nn = tid & 63, kk0 = tid >> 6;
#pragma unroll
    for (int i = 0; i < 8; ++i) {
      int kk = kk0 + 8 * i;
      float v = 0.f;
      if (n0 + nn < N) {
        v = src[(size_t)(k0 + kk) * N + n0 + nn];
        if (scale) v *= scale[k0 + kk];
      }
      tile[kk][nn] = v;
    }
  }
  __syncthreads();
  {
    int kk = tid & 63, nn0 = tid >> 6;
#pragma unroll
    for (int i = 0; i < 8; ++i) {
      int nn = nn0 + 8 * i;
      if (n0 + nn < N) dst[(size_t)(n0 + nn) * (ldd ? ldd : K) + k0 + kk] = (h16)tile[kk][nn];
    }
  }
  __syncthreads();
}

__device__ void phase_prep(const Params& p, char* shm) {
  CTX;
  constexpr int T_IN = 117 * 16, T_UA = 16 * 8, T_UC = 16 * 16, T_F = 64 * 16, T_SP = 16;
  constexpr int PER = T_IN + 2 * T_UA + 2 * T_UC + 2 * T_F + T_SP;
  for (int item = BIDX; item < PER * NLAYER; item += gridDim.x) {
    int l = item / PER, r = item % PER;
    h16* wl = p.wt + (size_t)l * WL;
    if (r < T_IN) { prep_tile(p.w_in + (size_t)l * 1024 * LDP, 1024, LDP, wl + O_WIN, p.norm_mix_g + l * 1024, r / 16, r % 16, shm); continue; }
    r -= T_IN;
    if (r < T_UA) { prep_tile(p.w_up_attn + (size_t)l * 512 * 1024, 512, 1024, wl + O_UPA, nullptr, r / 8, r % 8, shm); continue; }
    r -= T_UA;
    if (r < T_UA) { prep_tile(p.w_up_gmlp + (size_t)l * 512 * 1024, 512, 1024, wl + O_UPB, nullptr, r / 8, r % 8, shm); continue; }
    r -= T_UA;
    if (r < T_UC) { int hf = r >> 7, rr = r & 127; prep_tile(p.w_up_ssd + (size_t)l * 1024 * 1024 + (size_t)hf * 512 * 1024, 512, 1024, wl + O_UPC + hf * 524288, p.ssd_norm_g + l * 1024 + hf * 512, rr / 8, rr % 8, shm); continue; }
    r -= T_UC;
    if (r < T_UC) { prep_tile(p.w_out + (size_t)l * 1024 * 1024, 1024, 1024, wl + O_WOUT, nullptr, r / 16, r % 16, shm); continue; }
    r -= T_UC;
    if (r < T_F) { prep_tile(p.w_ff1 + (size_t)l * 1024 * 4096, 1024, 4096, wl + O_FF1, p.norm_ff_g + l * 1024, r / 16, r % 16, shm); continue; }
    r -= T_F;
    if (r < T_F) { prep_tile(p.w_ff2 + (size_t)l * 4096 * 1024, 4096, 1024, wl + O_FF2, nullptr, r / 64, r % 64, shm, LDH); continue; }
    r -= T_F;
    {
      const float* s = p.w_spatial + (size_t)l * 65536 + r * 4096;
      h16* d = wl + O_WSP + r * 4096;
      for (int i = TIDX; i < 4096; i += 512) d[i] = (h16)s[i];
    }
  }
}

__device__ void phase_pre(const Params& p, int g) {
  CTX;
  const float* xin = (g < 2) ? p.x_prompt + (size_t)g * TG * 1024 : p.x_sample;
  float* xo = p.out + (size_t)g * TG * 1024;
  const int wid = TIDX >> 6, lane = TIDX & 63;
  for (int row = BIDX * 8 + wid; row < TG; row += gridDim.x * 8) {
    const float4* s4 = (const float4*)(xin + (size_t)row * 1024);
    float4* d4 = (float4*)(xo + (size_t)row * 1024);
    float ss = 0.f;
#pragma unroll
    for (int i = 0; i < 4; ++i) {
      int idx = i * 64 + lane;
      float4 v = s4[idx];
      d4[idx] = v;
      ss += v.x * v.x + v.y * v.y + v.z * v.z + v.w * v.w;
      h16x4 hv = {(h16)v.x, (h16)v.y, (h16)v.z, (h16)v.w};
      *(h16x4*)(p.bufA + (size_t)row * 1024 + idx * 4) = hv;
    }
    ss = wave_sum(ss);
    if (lane == 0) p.rssX[row] = ss;
  }
}

#define LAS __attribute__((address_space(3)))
constexpr int BK = 64, HALF = 128, HTB = HALF * BK * 2;
__device__ __forceinline__ int lds_byte(int r, int c) {
  const int st = (r >> 4) * 2 + (c >> 5), rr = r & 15, cc = c & 31, ob = rr * 64 + cc * 2;
  return st * 1024 + (ob ^ (((ob >> 9) & 1) << 5));
}
__device__ __forceinline__ void stage_rc(int b, int& R, int& C) {
  const int st = b / 1024, sb = b % 1024, swz = sb ^ (((sb >> 9) & 1) << 5);
  R = (st >> 1) * 16 + swz / 64;
  C = (st & 1) * 32 + (swz % 64) / 2;
}
__device__ __forceinline__ int perm32(int rho) { const int n = rho >> 4, i = rho & 15; return 8 * (i >> 2) + 4 * n + (i & 3); }

struct Unit { const char* A; const char* B; int pm, pn, seg; };

__device__ __forceinline__ void tile_map(int t, int total, int nN, int& pm, int& pn) {
  int base = t & ~255, i = t & 255;
  int R = min(256, total - base);
  int id = (R & 7) ? t : base + (i & 7) * (R >> 3) + (i >> 3);
  int band = id / (8 * nN), w = id % (8 * nN);
  pm = band * 8 + (w & 7);
  pn = w >> 3;
}

template <class Sched, class Epi>
__device__ __forceinline__ void gemm_phase(LAS unsigned char* lds, const int lda, const int ldb, const int nt, const Sched& S, const Epi& E) {
  CTX;
  const int tid = TIDX, wid = __builtin_amdgcn_readfirstlane(tid >> 6), lane = tid & 63, wr = wid >> 2, wc = wid & 3, fr = lane & 15, fq = lane >> 4;
  unsigned voffA[2], voffB[2];
#pragma unroll
  for (int i = 0; i < 2; ++i) {
    int R, C;
    stage_rc(tid * 16 + i * 8192, R, C);
    const int Rb = (R & ~31) + perm32(R & 31);
    voffA[i] = (unsigned)(R * lda + C) * 2u;
    voffB[i] = (unsigned)(Rb * ldb + C) * 2u;
  }
  const size_t kstep = (size_t)(BK * 2);
  const size_t hstepA = (size_t)HALF * lda * 2, hstepB = (size_t)HALF * ldb * 2;
  const unsigned ldsw = (unsigned)wid * 1024u;
  const int aoff = lds_byte(wr * 64 + fr, fq * 8), boff = lds_byte(wc * 32 + fr, fq * 8);
#define G_SA(b, h) (((b)*2 + (h)) * HTB)
#define G_SB(b, h) ((4 + (b)*2 + (h)) * HTB)
#define G_STAGE(bufoff, gbase, voff)                                                                                        \
  do {                                                                                                                      \
    _Pragma("unroll") for (int _i = 0; _i < 2; ++_i) __builtin_amdgcn_global_load_lds(                                      \
        (const unsigned*)((const char*)(gbase) + (voff)[_i]), (LAS unsigned*)(lds + (bufoff) + ldsw + _i * 8192), 16, 0, 0); \
  } while (0)
#define G_LDA(dst, b, h)                                                                                                    \
  do {                                                                                                                      \
    _Pragma("unroll") for (int m = 0; m < 4; ++m) _Pragma("unroll") for (int k = 0; k < 2; ++k) dst[m][k] =                 \
        *(const LAS h16x8*)(lds + G_SA(b, h) + aoff + m * 2048 + k * 1024);                                                 \
  } while (0)
#define G_LDB(dst, b, h)                                                                                                    \
  do {                                                                                                                      \
    _Pragma("unroll") for (int n = 0; n < 2; ++n) _Pragma("unroll") for (int k = 0; k < 2; ++k) dst[n][k] =                 \
        *(const LAS h16x8*)(lds + G_SB(b, h) + boff + n * 2048 + k * 1024);                                                 \
  } while (0)
#define G_MMA(ai, bj, At_, Bt_)                                                                                             \
  do {                                                                                                                      \
    __builtin_amdgcn_s_setprio(1);                                                                                          \
    _Pragma("unroll") for (int m = 0; m < 4; ++m) _Pragma("unroll") for (int n = 0; n < 2; ++n)                             \
    _Pragma("unroll") for (int k = 0; k < 2; ++k) acc[ai][bj][m][n] =                                                       \
        __builtin_amdgcn_mfma_f32_16x16x32_f16(Bt_[n][k], At_[m][k], acc[ai][bj][m][n], 0, 0, 0);                           \
    __builtin_amdgcn_s_setprio(0);                                                                                          \
  } while (0)
#define G_WAIT_V(n) asm volatile("s_waitcnt vmcnt(" #n ")" ::: "memory")
#define G_WAIT_L(n) asm volatile("s_waitcnt lgkmcnt(" #n ")" ::: "memory")
#define G_BAR __builtin_amdgcn_s_barrier()
#define G_SCHED __builtin_amdgcn_sched_barrier(0)
#define G_ZERO                                                                                       \
  _Pragma("unroll") for (int a = 0; a < 2; ++a) _Pragma("unroll") for (int b = 0; b < 2; ++b)        \
  _Pragma("unroll") for (int m = 0; m < 4; ++m) _Pragma("unroll") for (int n = 0; n < 2; ++n) acc[a][b][m][n] = f32x4{0.f, 0.f, 0.f, 0.f}
  Unit cur, nxt;
  int ui = 0;
  if (!S.next(0, cur)) return;
  f32x4 acc[2][2][4][2];
  G_ZERO;
  h16x8 At[4][2], B0[2][2], B1[2][2];
  const char* cA = cur.A;
  const char* cB = cur.B;
  G_STAGE(G_SB(0, 0), cB, voffB); G_STAGE(G_SA(0, 0), cA, voffA); G_STAGE(G_SB(0, 1), cB + hstepB, voffB); G_STAGE(G_SA(0, 1), cA + hstepA, voffA);
  if (wr == 1) G_BAR;
  G_WAIT_V(4); G_BAR;
  G_STAGE(G_SB(1, 0), cB + kstep, voffB); G_STAGE(G_SA(1, 0), cA + kstep, voffA); G_STAGE(G_SB(1, 1), cB + hstepB + kstep, voffB);
  G_WAIT_V(6); G_BAR;
  for (;;) {
    const typename Epi::Pre pre = E.prefetch(cur, wr, fr);
    const bool has_next = S.next(ui + 1, nxt);
    const char* nA = has_next ? nxt.A : cA;
    const char* nB = has_next ? nxt.B : cB;
    for (int t = 0; t < nt; t += 2) {
      const bool last = (t == nt - 2);
      const char* a1 = cA + (size_t)(t + 1) * kstep;
      const char* a2 = last ? nA : cA + (size_t)(t + 2) * kstep;
      const char* b2 = last ? nB : cB + (size_t)(t + 2) * kstep;
      const char* a3 = a2 + kstep;
      const char* b3 = b2 + kstep;
      G_LDB(B0, 0, 0); G_SCHED; G_LDA(At, 0, 0); G_STAGE(G_SA(1, 1), a1 + hstepA, voffA);
      G_WAIT_L(8); G_BAR; G_WAIT_L(0); G_MMA(0, 0, At, B0); G_BAR; G_SCHED;
      G_LDB(B1, 0, 1); G_STAGE(G_SB(0, 0), b2, voffB);
      G_BAR; G_WAIT_L(0); G_MMA(0, 1, At, B1); G_BAR;
      G_LDA(At, 0, 1); G_STAGE(G_SA(0, 0), a2, voffA);
      G_BAR; G_WAIT_L(0); G_MMA(1, 0, At, B0); G_BAR; G_SCHED;
      G_STAGE(G_SB(0, 1), b2 + hstepB, voffB);
      G_WAIT_V(6); G_BAR; G_MMA(1, 1, At, B1); G_BAR;
      G_LDB(B0, 1, 0); G_SCHED; G_LDA(At, 1, 0); G_STAGE(G_SA(0, 1), a2 + hstepA, voffA);
      G_WAIT_L(8); G_BAR; G_WAIT_L(0); G_MMA(0, 0, At, B0); G_BAR; G_SCHED;
      G_LDB(B1, 1, 1); G_STAGE(G_SB(1, 0), b3, voffB);
      G_BAR; G_WAIT_L(0); G_MMA(0, 1, At, B1); G_BAR;
      G_LDA(At, 1, 1); G_STAGE(G_SA(1, 0), a3, voffA);
      G_BAR; G_WAIT_L(0); G_MMA(1, 0, At, B0); G_BAR; G_SCHED;
      G_STAGE(G_SB(1, 1), b3 + hstepB, voffB);
      G_WAIT_V(6); G_BAR; G_MMA(1, 1, At, B1); G_BAR;
    }
    int fr_o = fr, fq_o = fq;
    asm volatile("" : "+v"(fr_o), "+v"(fq_o));
    const bool clr = E(acc, cur, pre, wr, wc, fr_o, fq_o);
    if (!has_next) break;
    if (clr) { G_ZERO; }
    cur = nxt; cA = nA; cB = nB; ++ui;
  }
  G_WAIT_V(0);
  if (wr == 0) G_BAR;
  G_BAR;
}

struct SchedTiles {
  const char *A, *B; size_t tstepA, tstepB; int nN, total, G, c;
  __device__ __forceinline__ bool next(int i, Unit& u) const {
    const long L = (long)i * G + c;
    if (L >= total) return false;
    tile_map((int)L, total, nN, u.pm, u.pn);
    u.A = A + (size_t)u.pm * tstepA; u.B = B + (size_t)u.pn * tstepB; u.seg = 0;
    return true;
  }
};
struct SchedMerge {
  const char *proj, *wl; int G, c;
  __device__ __forceinline__ bool next(int i, Unit& u) const {
    const int tile = (i >> 2) * G + c;
    if (tile >= 256) return false;
    const int seg = i & 3;
    tile_map(tile, 256, 4, u.pm, u.pn);
    const int acol = seg == 0 ? CQ : seg == 1 ? CGU : seg == 2 ? CZ : CZ + 512;
    const long bo = seg == 0 ? O_UPA : seg == 1 ? O_UPB : seg == 2 ? O_UPC : O_UPC + 524288;
    u.A = proj + ((size_t)u.pm * 256 * LDP + acol) * 2;
    u.B = wl + ((size_t)bo + (size_t)u.pn * 256 * 512) * 2;
    u.seg = seg;
    return true;
  }
};

#define FOR_ROWS _Pragma("unroll") for (int ai = 0; ai < 2; ++ai) _Pragma("unroll") for (int m = 0; m < 4; ++m)
__device__ __forceinline__ h16x8 pack8(f32x4 a, f32x4 b) {
  h16x8 r = {(h16)a[0], (h16)a[1], (h16)a[2], (h16)a[3], (h16)b[0], (h16)b[1], (h16)b[2], (h16)b[3]};
  return r;
}

struct EpiInproj {
  h16* proj; float* dtbuf; const float* rss;
  struct Pre { float v[8]; };
  __device__ __forceinline__ Pre prefetch(const Unit& u, int wr, int fr) const {
    Pre q;
    const int row0 = u.pm * 256 + wr * 64 + fr;
#pragma unroll
    for (int r8 = 0; r8 < 8; ++r8) q.v[r8] = rss[row0 + (r8 >> 2) * 128 + (r8 & 3) * 16];
    return q;
  }
  __device__ __forceinline__ bool operator()(f32x4 (&acc)[2][2][4][2], const Unit& u, const Pre& pre, int wr, int wc, int fr, int fq) const {
    const int row0 = u.pm * 256 + wr * 64 + fr, col0 = u.pn * 256 + wc * 32 + 8 * fq;
    FOR_ROWS {
      const size_t row = row0 + ai * 128 + m * 16;
      const float rs = rsqrtf(pre.v[ai * 4 + m] * (1.f / 1024.f) + EPS);
      h16* rp = proj + row * LDP + col0;
#pragma unroll
      for (int bj = 0; bj < 2; ++bj) {
        const int col = col0 + bj * 128;
        if (col < LDP) {
          f32x4 v0 = acc[ai][bj][m][0] * rs, v1 = acc[ai][bj][m][1] * rs;
          if (col >= CG) {
#pragma unroll
            for (int j = 0; j < 4; ++j) {
              v0[j] = fmaxf(__builtin_amdgcn_rcpf(1.f + __expf(-v0[j])), 6.2e-5f);
              v1[j] = fmaxf(__builtin_amdgcn_rcpf(1.f + __expf(-v1[j])), 6.2e-5f);
            }
          }
          *(h16x8*)(rp + bj * 128) = pack8(v0, v1);
          if (col >= CDT && col < CDT + 32) {
            *(f32x4*)(dtbuf + row * 32 + (col - CDT)) = v0;
            *(f32x4*)(dtbuf + row * 32 + (col - CDT) + 4) = v1;
          }
        }
      }
    }
    return true;
  }
};

__device__ __forceinline__ float sig_ratio(float a, float b) {
  a = clampf(a, -30.f, 30.f);
  b = clampf(b, -30.f, 30.f);
  return (1.f + __expf(-b)) / (1.f + __expf(-a));
}
struct EpiMerge {
  const h16* proj; h16* dst; const float* ssq;
  struct Pre {};
  __device__ __forceinline__ Pre prefetch(const Unit&, int, int) const { return Pre{}; }
  __device__ __forceinline__ bool operator()(f32x4 (&acc)[2][2][4][2], const Unit& u, const Pre& pre, int wr, int wc, int fr, int fq) const {
    const int row0 = u.pm * 256 + wr * 64 + fr, col0 = u.pn * 256 + wc * 32 + 8 * fq;
    const int seg = u.seg;
    const int go = (seg == 3) ? 2048 : seg * 1024;
    const h16x8 one = {1, 1, 1, 1, 1, 1, 1, 1};
    float2 sq[8];
#pragma unroll
    for (int r8 = 0; r8 < 8; ++r8) sq[r8] = *(const float2*)(ssq + (size_t)(row0 + (r8 >> 2) * 128 + (r8 & 3) * 16) * 2);
    h16x8 c0[2] = {one, one}, c1[2] = {one, one}, n0[2] = {one, one}, n1[2] = {one, one};
    {
      const h16* gp = proj + (size_t)row0 * LDP + CG + col0 + go;
      if (seg != 2) { c0[0] = *(const h16x8*)gp; c0[1] = *(const h16x8*)(gp + 128); }
      if (seg < 2) { c1[0] = *(const h16x8*)(gp + 1024); c1[1] = *(const h16x8*)(gp + 1024 + 128); }
    }
#pragma unroll
    for (int r8 = 0; r8 < 8; ++r8) {
      const int ai = r8 >> 2, m = r8 & 3;
      const size_t row = row0 + ai * 128 + m * 16;
      if (r8 < 7) {
        const h16* gp = proj + (size_t)(row0 + ((r8 + 1) >> 2) * 128 + ((r8 + 1) & 3) * 16) * LDP + CG + col0 + go;
        if (seg != 2) { n0[0] = *(const h16x8*)gp; n0[1] = *(const h16x8*)(gp + 128); }
        if (seg < 2) { n1[0] = *(const h16x8*)(gp + 1024); n1[1] = *(const h16x8*)(gp + 1024 + 128); }
      }
      const float q0 = sq[r8].x * (1.f / 512.f) + EPS, q1 = sq[r8].y * (1.f / 512.f) + EPS;
      const float f = (seg == 0) ? 1.f : (seg == 1) ? sqrtf(q0) : (seg == 2) ? rsqrtf(q0) * sqrtf(q1) : rsqrtf(q1);
#pragma unroll
      for (int bj = 0; bj < 2; ++bj) {
#pragma unroll
        for (int j = 0; j < 4; ++j) {
          acc[ai][bj][m][0][j] *= (float)c0[bj][j] * __builtin_amdgcn_rcpf((float)c1[bj][j]) * f;
          acc[ai][bj][m][1][j] *= (float)c0[bj][4 + j] * __builtin_amdgcn_rcpf((float)c1[bj][4 + j]) * f;
        }
        if (seg == 3) *(h16x8*)(dst + row * 1024 + col0 + bj * 128) = pack8(acc[ai][bj][m][0], acc[ai][bj][m][1]);
      }
#pragma unroll
      for (int k = 0; k < 2; ++k) { c0[k] = n0[k]; c1[k] = n1[k]; }
    }
    return seg == 3;
  }
};

struct EpiResid {
  float* xo; h16* copy; float* rss; int feed;
  struct Pre {};
  __device__ __forceinline__ Pre prefetch(const Unit&, int, int) const { return Pre{}; }
  __device__ __forceinline__ bool operator()(f32x4 (&acc)[2][2][4][2], const Unit& u, const Pre& pre, int wr, int wc, int fr, int fq) const {
    const int row0 = u.pm * 256 + wr * 64 + fr, col0 = u.pn * 256 + wc * 32 + 8 * fq;
    f32x4 cur[4], nxt[4];
    {
      const float* xp = xo + (size_t)row0 * 1024 + col0;
      cur[0] = *(const f32x4*)xp; cur[1] = *(const f32x4*)(xp + 4); cur[2] = *(const f32x4*)(xp + 128); cur[3] = *(const f32x4*)(xp + 132);
    }
#pragma unroll
    for (int r8 = 0; r8 < 8; ++r8) {
      const int ai = r8 >> 2, m = r8 & 3;
      const size_t row = row0 + ai * 128 + m * 16;
      if (r8 < 7) {
        const float* xp = xo + (size_t)(row0 + ((r8 + 1) >> 2) * 128 + ((r8 + 1) & 3) * 16) * 1024 + col0;
        nxt[0] = *(const f32x4*)xp; nxt[1] = *(const f32x4*)(xp + 4); nxt[2] = *(const f32x4*)(xp + 128); nxt[3] = *(const f32x4*)(xp + 132);
      }
      float ss = 0.f;
#pragma unroll
      for (int bj = 0; bj < 2; ++bj) {
        float* xp = xo + row * 1024 + col0 + bj * 128;
        f32x4 v0 = cur[bj * 2] + acc[ai][bj][m][0], v1 = cur[bj * 2 + 1] + acc[ai][bj][m][1];
        *(f32x4*)xp = v0;
        *(f32x4*)(xp + 4) = v1;
        if (feed) *(h16x8*)(copy + row * 1024 + col0 + bj * 128) = pack8(v0, v1);
#pragma unroll
        for (int j = 0; j < 4; ++j) ss += v0[j] * v0[j] + v1[j] * v1[j];
      }
      ss += __shfl_xor(ss, 16, 64);
      ss += __shfl_xor(ss, 32, 64);
      if (fq == 0 && feed) atomicAdd(rss + row, ss);
#pragma unroll
      for (int k = 0; k < 4; ++k) cur[k] = nxt[k];
    }
    return true;
  }
};

struct EpiFF1 {
  h16* hid; const float* rss;
  struct Pre { float v[8]; };
  __device__ __forceinline__ Pre prefetch(const Unit& u, int wr, int fr) const {
    Pre q;
    const int row0 = u.pm * 256 + wr * 64 + fr;
#pragma unroll
    for (int r8 = 0; r8 < 8; ++r8) q.v[r8] = rss[row0 + (r8 >> 2) * 128 + (r8 & 3) * 16];
    return q;
  }
  __device__ __forceinline__ bool operator()(f32x4 (&acc)[2][2][4][2], const Unit& u, const Pre& pre, int wr, int wc, int fr, int fq) const {
    const int row0 = u.pm * 256 + wr * 64 + fr, col0 = u.pn * 256 + wc * 32 + 8 * fq;
    FOR_ROWS {
      const size_t row = row0 + ai * 128 + m * 16;
      const float rs = rsqrtf(pre.v[ai * 4 + m] * (1.f / 1024.f) + EPS);
#pragma unroll
      for (int bj = 0; bj < 2; ++bj) {
        f32x4 v0 = acc[ai][bj][m][0] * rs, v1 = acc[ai][bj][m][1] * rs;
#pragma unroll
        for (int j = 0; j < 4; ++j) {
          float a = fmaxf(v0[j], 0.f), b = fmaxf(v1[j], 0.f);
          v0[j] = a * a; v1[j] = b * b;
        }
        *(h16x8*)(hid + row * LDH + col0 + bj * 128) = pack8(v0, v1);
      }
    }
    return true;
  }
};

__device__ __forceinline__ void zero_f32(float* p, int n) {
  CTX;
  for (int i = BIDX * 512 + TIDX; i < n; i += gridDim.x * 512) p[i] = 0.f;
}

__device__ void phase_inproj(const Params& p, int l, char* shm) {
  CTX;
  zero_f32(p.rssH, TG);
  SchedTiles S{(const char*)p.bufA, (const char*)(p.wt + (size_t)l * WL + O_WIN), (size_t)256 * 1024 * 2, (size_t)256 * 1024 * 2, 30, 64 * 30, (int)gridDim.x, (int)BIDX};
  EpiInproj E{p.proj, p.dtbuf, p.rssX};
  gemm_phase((LAS unsigned char*)shm, 1024, 1024, 16, S, E);
}
__device__ void phase_merge(const Params& p, int l, char* shm) {
  CTX;
  SchedMerge S{(const char*)p.proj, (const char*)(p.wt + (size_t)l * WL), (int)gridDim.x, (int)BIDX};
  EpiMerge E{p.proj, p.bufA, p.ssq};
  gemm_phase((LAS unsigned char*)shm, LDP, 512, 8, S, E);
}
__device__ void phase_wout(const Params& p, int g, int l, char* shm) {
  CTX;
  SchedTiles S{(const char*)p.bufA, (const char*)(p.wt + (size_t)l * WL + O_WOUT), (size_t)256 * 1024 * 2, (size_t)256 * 1024 * 2, 4, 256, (int)gridDim.x, (int)BIDX};
  EpiResid E{p.out + (size_t)g * TG * 1024, p.bufB, p.rssH, 1};
  gemm_phase((LAS unsigned char*)shm, 1024, 1024, 16, S, E);
}
__device__ void phase_ff1(const Params& p, int l, char* shm) {
  CTX;
  zero_f32(p.rssX, TG);
  SchedTiles S{(const char*)p.bufB, (const char*)(p.wt + (size_t)l * WL + O_FF1), (size_t)256 * 1024 * 2, (size_t)256 * 1024 * 2, 16, 64 * 16, (int)gridDim.x, (int)BIDX};
  EpiFF1 E{p.proj, p.rssH};
  gemm_phase((LAS unsigned char*)shm, 1024, 1024, 16, S, E);
}
__device__ void phase_ff2(const Params& p, int g, int l, char* shm) {
  CTX;
  SchedTiles S{(const char*)p.proj, (const char*)(p.wt + (size_t)l * WL + O_FF2), (size_t)256 * LDH * 2, (size_t)256 * LDH * 2, 4, 256, (int)gridDim.x, (int)BIDX};
  EpiResid E{p.out + (size_t)g * TG * 1024, p.bufA, p.rssX, l < NLAYER - 1};
  gemm_phase((LAS unsigned char*)shm, LDH, LDH, 64, S, E);
}

__device__ __forceinline__ int t5_bucket(int rel) {
  int ret = rel > 0 ? 16 : 0;
  int n = rel < 0 ? -rel : rel;
  if (n < 8) return ret + n;
  int large = 8;
#pragma unroll
  for (int k = 1; k <= 7; ++k) large += (n * n >= (64 << k)) ? 1 : 0;
  return ret + min(large, 15);
}

__device__ void phase_attn(const Params& p, int g, int l, char* shm, int dry) {
  CTX;
  const int S = (g < 2) ? 2048 : 8192;
  constexpr int KS = 72, KP = 408;
  h16* Ks = (h16*)shm;
  h16* VT = Ks + 384 * KS;
  float* bias_s = (float*)(VT + 64 * KP);
  const int wid = TIDX >> 6, lane = TIDX & 63, fr = lane & 15, fq = lane >> 4;
  const float* kg = p.k_norm_g + l * 64;
  const float* qg = p.q_norm_g + l * 64;
  const int nitems = (TG / 128) * 2;
  for (int item = BIDX; item < nitems; item += gridDim.x) {
    const int hk = item & 1, blk = item >> 1;
    const int t0 = blk * 128, seq = t0 / S, q0 = t0 % S;
#pragma unroll
    for (int i = TIDX; i < 4 * 257; i += 512) {
      int gq = i / 257, rel = i % 257 - 128;
      bias_s[i] = p.rel_bias[t5_bucket(rel) * 8 + hk * 4 + gq];
    }
    const int gq = wid >> 1, hq = hk * 4 + gq;
    h16x8 qa_n, qb_n;
    {
      const h16* qr0 = p.proj + (size_t)(seq * S + q0 + (wid & 1) * 64 + fr) * LDP + CQ + hq * 64;
      qa_n = *(const h16x8*)(qr0 + fq * 8); qb_n = *(const h16x8*)(qr0 + 32 + fq * 8);
    }
    float qgA[8], qgB[8];
#pragma unroll
    for (int j = 0; j < 8; ++j) { qgA[j] = qg[fq * 8 + j]; qgB[j] = qg[32 + fq * 8 + j]; }
    for (int i = TIDX; i < 64 * 24; i += 512) VT[(i / 24) * KP + 384 + (i % 24)] = (h16)0.f;
    {
      h16x8 kvr[6], vvr[6];
#pragma unroll
      for (int k = 0; k < 6; ++k) {
        int task = TIDX + k * 512, r = task >> 3, c = (task & 7) * 8;
        int kp = q0 - 128 + r;
        const h16x8 zero = {0, 0, 0, 0, 0, 0, 0, 0};
        const bool valid = (kp >= 0) && (kp < S);
        const h16* rp = p.proj + (size_t)(seq * S + min(max(kp, 0), S - 1)) * LDP;
        kvr[k] = *(const h16x8*)(rp + CK + hk * 64 + c);
        vvr[k] = *(const h16x8*)(rp + CV + hk * 64 + c);
        kvr[k] = valid ? kvr[k] : zero;
        vvr[k] = valid ? vvr[k] : zero;
      }
#pragma unroll
      for (int k = 0; k < 6; ++k) {
        int task = TIDX + k * 512, r = task >> 3, c = (task & 7) * 8;
        float kf[8], ss = 0.f;
#pragma unroll
        for (int j = 0; j < 8; ++j) { kf[j] = (float)kvr[k][j]; ss += kf[j] * kf[j]; }
        ss += __shfl_xor(ss, 1, 64);
        ss += __shfl_xor(ss, 2, 64);
        ss += __shfl_xor(ss, 4, 64);
        float rs = rsqrtf(ss * (1.f / 64.f) + EPS);
        h16x8 kn;
#pragma unroll
        for (int j = 0; j < 8; ++j) { kn[j] = (h16)(kf[j] * rs * kg[c + j]); VT[(c + j) * KP + r] = vvr[k][j]; }
        *(h16x8*)(Ks + r * KS + c) = kn;
      }
    }
    __syncthreads();
    const bool edge = (q0 == 0) || (q0 == S - 128);
    const float sinkv = p.attn_sink[l * 8 + hq];
#pragma unroll 1
    for (int qi = 0; qi < 4; ++qi) {
      const int qt = (wid & 1) * 4 + qi, i = qt * 16 + fr;
      h16* qrow = p.proj + (size_t)(seq * S + q0 + i) * LDP + CQ + hq * 64;
      h16x8 qa = qa_n, qb = qb_n;
      if (qi < 3) {
        const h16* qrn = qrow + (size_t)16 * LDP;
        qa_n = *(const h16x8*)(qrn + fq * 8); qb_n = *(const h16x8*)(qrn + 32 + fq * 8);
      }
      {
        float ss = 0.f;
#pragma unroll
        for (int j = 0; j < 8; ++j) ss += (float)qa[j] * (float)qa[j] + (float)qb[j] * (float)qb[j];
        ss += __shfl_xor(ss, 16, 64);
        ss += __shfl_xor(ss, 32, 64);
        const float rs = rsqrtf(ss * (1.f / 64.f) + EPS) * 0.125f;
#pragma unroll
        for (int j = 0; j < 8; ++j) {
          qa[j] = (h16)((float)qa[j] * rs * qgA[j]);
          qb[j] = (h16)((float)qb[j] * rs * qgB[j]);
        }
      }
      f32x4 sc[18];
#pragma unroll
      for (int kt = 0; kt < 17; ++kt) {
        const h16* kr = Ks + ((qt + kt) * 16 + fr) * KS + fq * 8;
        f32x4 acc = {0.f, 0.f, 0.f, 0.f};
        acc = __builtin_amdgcn_mfma_f32_16x16x32_f16(*(const h16x8*)kr, qa, acc, 0, 0, 0);
        acc = __builtin_amdgcn_mfma_f32_16x16x32_f16(*(const h16x8*)(kr + 32), qb, acc, 0, 0, 0);
        sc[kt] = acc;
      }
      sc[17] = f32x4{0.f, 0.f, 0.f, 0.f};
      float mx = sinkv;
      const int d0 = 4 * fq - fr;
      const float* bl = bias_s + gq * 257 + d0;
      if (!edge) {
#pragma unroll
        for (int kt = 0; kt < 17; ++kt) {
#pragma unroll
          for (int j = 0; j < 4; ++j) {
            const int rel = kt * 16 + d0 + j;
            float s;
            if (kt == 0) s = (rel >= 0) ? sc[kt][j] + bl[max(j, -d0)] : -1e30f;
            else if (kt == 16) s = (rel <= 256) ? sc[kt][j] + bl[min(256 + j, 256 - d0)] : -1e30f;
            else s = sc[kt][j] + bl[kt * 16 + j];
            sc[kt][j] = s;
            mx = fmaxf(mx, s);
          }
        }
      } else {
#pragma unroll
        for (int kt = 0; kt < 17; ++kt) {
#pragma unroll
          for (int j = 0; j < 4; ++j) {
            const int r = (qt + kt) * 16 + 4 * fq + j, rel = r - i, kp = q0 - 128 + r;
            const bool valid = (rel >= 0) && (rel <= 256) && (kp >= 0) && (kp < S);
            const float s = valid ? sc[kt][j] + bias_s[gq * 257 + min(max(rel, 0), 256)] : -1e30f;
            sc[kt][j] = s;
            mx = fmaxf(mx, s);
          }
        }
      }
      mx = fmaxf(mx, __shfl_xor(mx, 16, 64));
      mx = fmaxf(mx, __shfl_xor(mx, 32, 64));
      float sum = 0.f;
#pragma unroll
      for (int kt = 0; kt < 17; ++kt) {
#pragma unroll
        for (int j = 0; j < 4; ++j) { float pe = __expf(sc[kt][j] - mx); sc[kt][j] = pe; sum += pe; }
      }
      sum += __shfl_xor(sum, 16, 64);
      sum += __shfl_xor(sum, 32, 64);
      sum += __expf(sinkv - mx);
      const float inv = 1.f / sum;
      h16x8 pb[9];
#pragma unroll
      for (int u = 0; u < 9; ++u) {
#pragma unroll
        for (int j = 0; j < 4; ++j) { pb[u][j] = (h16)sc[2 * u][j]; pb[u][4 + j] = (h16)sc[2 * u + 1][j]; }
      }
#pragma unroll
      for (int dt = 0; dt < 4; ++dt) {
        f32x4 acc = {0.f, 0.f, 0.f, 0.f};
        const h16* vr = VT + (dt * 16 + fr) * KP + qt * 16 + 4 * fq;
#pragma unroll
        for (int u = 0; u < 9; ++u) {
          h16x4 va = *(const h16x4*)(vr + u * 32), vb = *(const h16x4*)(vr + u * 32 + 16);
          h16x8 a = {va[0], va[1], va[2], va[3], vb[0], vb[1], vb[2], vb[3]};
          acc = __builtin_amdgcn_mfma_f32_16x16x32_f16(a, pb[u], acc, 0, 0, 0);
        }
        h16x4 ov = {(h16)(acc[0] * inv), (h16)(acc[1] * inv), (h16)(acc[2] * inv), (h16)(acc[3] * inv)};
        if (!dry) *(h16x4*)(qrow + dt * 16 + 4 * fq) = ov;
      }
    }
    __syncthreads();
  }
}

__device__ void phase_gmlp(const Params& p, int l, char* shm, int dry) {
  CTX;
  constexpr int GP = 136;
  h16* vnT = (h16*)shm;
  h16* Ws = vnT + 128 * GP;
  float* mean_s = (float*)(Ws + 128 * GP);
  float* rstd_s = mean_s + 128;
  const int wid = TIDX >> 6, lane = TIDX & 63, fr = lane & 15, fq = lane >> 4;
  const float* lng = p.gmlp_ln_g + l * 512;
  const float* lnb = p.gmlp_ln_b + l * 512;
  const int nitems = (TG / 128) * 2;
  for (int item = BIDX; item < nitems; item += gridDim.x) {
    const int half = item & 1, t0 = (item >> 1) * 128;
    const int row = TIDX >> 2, part = TIDX & 3;
    const h16* rp = p.proj + (size_t)(t0 + row) * LDP + CGV;
    {
      float sum = 0.f, sq = 0.f;
#pragma unroll
      for (int c = 0; c < 128; c += 8) {
        h16x8 v = *(const h16x8*)(rp + part * 128 + c);
#pragma unroll
        for (int j = 0; j < 8; ++j) { float ge = gelu_t((float)v[j]); sum += ge; sq += ge * ge; }
      }
      sum += __shfl_xor(sum, 1, 64); sum += __shfl_xor(sum, 2, 64);
      sq += __shfl_xor(sq, 1, 64); sq += __shfl_xor(sq, 2, 64);
      float mean = sum * (1.f / 512.f);
      float var = fmaxf(sq * (1.f / 512.f) - mean * mean, 0.f);
      if (part == 0) { mean_s[row] = mean; rstd_s[row] = rsqrtf(var + EPS); }
    }
#pragma unroll 1
    for (int gi = 0; gi < 2; ++gi) {
      const int grp = half * 2 + gi;
      __syncthreads();
      {
        const float mean = mean_s[row], rstd = rstd_s[row];
#pragma unroll
        for (int c = 0; c < 32; c += 8) {
          int cl = part * 32 + c;
          h16x8 v = *(const h16x8*)(rp + grp * 128 + cl);
#pragma unroll
          for (int j = 0; j < 8; ++j) {
            float ge = gelu_t((float)v[j]);
            vnT[(cl + j) * GP + row] = (h16)((ge - mean) * rstd * lng[grp * 128 + cl + j] + lnb[grp * 128 + cl + j]);
          }
        }
        const h16* w = p.wt + (size_t)l * WL + O_WSP + grp * 16384;
#pragma unroll
        for (int k = 0; k < 4; ++k) {
          int e = (TIDX + k * 512) * 8, tt = e >> 7, s0 = e & 127;
          *(h16x8*)(Ws + tt * GP + s0) = *(const h16x8*)(w + e);
        }
      }
      __syncthreads();
      const int t = wid * 16 + fr;
      h16x8 bfrag[4];
#pragma unroll
      for (int ks = 0; ks < 4; ++ks) bfrag[ks] = *(const h16x8*)(Ws + t * GP + ks * 32 + fq * 8);
      const float bsv = p.b_spatial[(size_t)l * 512 + grp * 128 + t];
      h16* ubase = p.proj + (size_t)(t0 + t) * LDP + CGU + grp * 128 + 4 * fq;
      h16x4 uvs[8];
#pragma unroll
      for (int et = 0; et < 8; ++et) uvs[et] = *(const h16x4*)(ubase + et * 16);
#pragma unroll
      for (int et = 0; et < 8; ++et) {
        f32x4 acc = {0.f, 0.f, 0.f, 0.f};
#pragma unroll
        for (int ks = 0; ks < 4; ++ks)
          acc = __builtin_amdgcn_mfma_f32_16x16x32_f16(*(const h16x8*)(vnT + (et * 16 + fr) * GP + ks * 32 + fq * 8), bfrag[ks], acc, 0, 0, 0);
        h16* up = ubase + et * 16;
        h16x4 uv = uvs[et], ov;
#pragma unroll
        for (int j = 0; j < 4; ++j) ov[j] = (h16)(gelu_t((float)uv[j]) * (acc[j] + bsv));
        if (!dry) *(h16x4*)up = ov;
      }
    }
    __syncthreads();
  }
}

constexpr int SP = 136;

#define CT_S(k, LOG) ((TIDX + (k)*512) >> (LOG))
#define CT_C8(k, LOG) (((TIDX + (k)*512) & ((1 << (LOG)) - 1)) * 8)
#define XROW(s) (p.proj + (size_t)(t0 + (s)) * LDP + CX)
#define HP(s) (tl0 + (s) > 0)
#define HN(s) (tl0 + (s) < S - 1)
__device__ __forceinline__ int swz_off(int row, int col) { return row * SP + ((((col >> 3) ^ ((row >> 3) & 7)) << 3) | (col & 7)); }
struct Raw3 { h16x8 p, c, n; };
__device__ __forceinline__ Raw3 conv_load(const h16* rp, bool hp, bool hn) {
  const h16x8 zero = {0, 0, 0, 0, 0, 0, 0, 0};
  Raw3 r;
  r.c = *(const h16x8*)rp;
  r.p = *(const h16x8*)(hp ? rp - LDP : rp);
  r.n = *(const h16x8*)(hn ? rp + LDP : rp);
  r.p = hp ? r.p : zero;
  r.n = hn ? r.n : zero;
  return r;
}
__device__ __forceinline__ void conv_apply(const Raw3& r, const float4* __restrict__ cwS, float (&o)[8]) {
#pragma unroll
  for (int j = 0; j < 8; ++j) {
    const float4 w = cwS[j];
    float v = w.w + (float)r.p[j] * w.x + (float)r.c[j] * w.y + (float)r.n[j] * w.z;
    o[j] = silu_f(v);
  }
}
__device__ __forceinline__ void ssd_dt_cum(const Params& p, int l, int t0, int grp, float* dts, float* cums, int TIDX) {
#pragma unroll
  for (int i = TIDX; i < 2048; i += 512) {
    int tok = i >> 4, j = i & 15, col = (j >> 3) * 16 + grp * 8 + (j & 7);
    float v = p.dtbuf[(size_t)(t0 + tok) * 32 + col] + p.dt_bias[l * 32 + col];
    dts[j * 128 + tok] = (v > 20.f) ? v : log1pf(expf(v));
  }
  __syncthreads();
  const int wid = TIDX >> 6, lane = TIDX & 63;
#pragma unroll
  for (int k = 0; k < 2; ++k) {
    const int combo = wid * 2 + k, dir = combo >> 3;
    const float a = -expf(p.a_log[l * 32 + dir * 16 + grp * 8 + (combo & 7)]);
    const int e0 = lane * 2;
    const int ta = dir ? 127 - e0 : e0, tb = dir ? 126 - e0 : e0 + 1;
    float v0 = dts[combo * 128 + ta] * a, v1 = dts[combo * 128 + tb] * a;
    float s = v0 + v1;
#pragma unroll
    for (int o = 1; o < 64; o <<= 1) {
      float n = __shfl_up(s, o, 64);
      if (lane >= o) s += n;
    }
    cums[combo * 128 + tb] = s;
    cums[combo * 128 + ta] = s - v1;
  }
  __syncthreads();
}

__device__ void phase_ssd_state(const Params& p, int g, int l, char* shm) {
  CTX;
  const int S = (g < 2) ? 2048 : 8192;
  h16* BT = (h16*)shm;
  h16* XT = BT + 128 * SP;
  float* dts = (float*)(XT + 64 * SP);
  float* cums = dts + 2048;
  h16* wv = (h16*)(cums + 2048);
  float4* cwS = (float4*)(wv + 2048);
  const int wid = TIDX >> 6, lane = TIDX & 63, fr = lane & 15, fq = lane >> 4;
  const float* cw = p.conv_w + (size_t)l * 4608;
  const float* cb = p.conv_b + (size_t)l * 1536;
  for (int item = BIDX; item < 256; item += gridDim.x) {
    const int grp = item & 1, ch = item >> 1, t0 = ch * 128, tl0 = t0 & (S - 1);
#pragma unroll
    for (int i = TIDX; i < 640; i += 512) {
      int c = (i < 128) ? 1024 + grp * 128 + i : grp * 512 + (i - 128);
      cwS[i] = float4{cw[c], cw[1536 + c], cw[3072 + c], cb[c]};
    }
    Raw3 br[4];
#pragma unroll
    for (int k = 0; k < 4; ++k) { const int s = CT_S(k, 4); br[k] = conv_load(XROW(s) + 1024 + grp * 128 + CT_C8(k, 4), HP(s), HN(s)); }
    Raw3 xr[2];
#pragma unroll
    for (int k = 0; k < 2; ++k) { const int s = CT_S(k, 3); xr[k] = conv_load(XROW(s) + grp * 512 + CT_C8(k, 3), HP(s), HN(s)); }
    ssd_dt_cum(p, l, t0, grp, dts, cums, TIDX);
#pragma unroll
    for (int i = TIDX; i < 2048; i += 512) {
      int combo = i >> 7;
      float cend = cums[combo * 128 + ((combo >> 3) ? 0 : 127)];
      wv[i] = (h16)(__expf(cend - cums[i]) * dts[i]);
    }
    if (TIDX < 16) p.dec[(ch * 2 + grp) * 16 + TIDX] = __expf(cums[TIDX * 128 + ((TIDX >> 3) ? 0 : 127)]);
#pragma unroll
    for (int k = 0; k < 4; ++k) {
      float o[8];
      const int s = CT_S(k, 4), c8 = CT_C8(k, 4);
      conv_apply(br[k], cwS + c8, o);
#pragma unroll
      for (int j = 0; j < 8; ++j) BT[swz_off(c8 + j, s)] = (h16)o[j];
    }
    __syncthreads();
    h16x8 af[4];
#pragma unroll
    for (int ks = 0; ks < 4; ++ks) af[ks] = *(const h16x8*)(BT + swz_off(wid * 16 + fr, ks * 32 + fq * 8));
#pragma unroll 1
    for (int hh = 0; hh < 8; ++hh) {
      __syncthreads();
#pragma unroll
      for (int k = 0; k < 2; ++k) {
        float o[8];
        const int s = CT_S(k, 3), c8 = CT_C8(k, 3);
        conv_apply(xr[k], cwS + 128 + hh * 64 + c8, o);
#pragma unroll
        for (int j = 0; j < 8; ++j) XT[swz_off(c8 + j, s)] = (h16)o[j];
      }
      if (hh < 7) {
#pragma unroll
        for (int k = 0; k < 2; ++k) { const int s = CT_S(k, 3); xr[k] = conv_load(XROW(s) + grp * 512 + (hh + 1) * 64 + CT_C8(k, 3), HP(s), HN(s)); }
      }
      __syncthreads();
#pragma unroll
      for (int dir = 0; dir < 2; ++dir) {
        const int combo = dir * 8 + hh;
        h16* stp = p.st + ((((size_t)ch * 2 + grp) * 2 + dir) * 8 + hh) * 8192;
#pragma unroll
        for (int pt = 0; pt < 4; ++pt) {
          f32x4 acc = {0.f, 0.f, 0.f, 0.f};
#pragma unroll
          for (int ks = 0; ks < 4; ++ks) {
            h16x8 xb = *(const h16x8*)(XT + swz_off(pt * 16 + fr, ks * 32 + fq * 8)) * *(const h16x8*)(wv + combo * 128 + ks * 32 + fq * 8);
            acc = __builtin_amdgcn_mfma_f32_16x16x32_f16(af[ks], xb, acc, 0, 0, 0);
          }
          h16x4 o4 = {(h16)acc[0], (h16)acc[1], (h16)acc[2], (h16)acc[3]};
          *(h16x4*)(stp + (pt * 16 + fr) * 128 + wid * 16 + 4 * fq) = o4;
        }
      }
    }
    __syncthreads();
  }
}

template <int W>
__device__ __forceinline__ void ssd_scan_body(const Params& p, int g, int dry, int TIDX, int BIDX) {
  typedef _Float16 hv __attribute__((ext_vector_type(W)));
  const int S = (g < 2) ? 2048 : 8192, nc = S / 128, nseq = TG / S;
  constexpr int VPC = 8192 / W;
  const int total = nseq * 32 * VPC;
  for (int idx = BIDX * 512 + TIDX; idx < total; idx += gridDim.x * 512) {
    const int v = idx % VPC, combo = (idx / VPC) & 31, seq = idx / (VPC * 32), dir = (combo >> 3) & 1;
    float carry[W];
#pragma unroll
    for (int j = 0; j < W; ++j) carry[j] = 0.f;
    for (int i = 0; i < nc; i += 8) {
      hv L[8]; float d[8]; h16* ptr[8];
#pragma unroll
      for (int u = 0; u < 8; ++u) {
        int c = dir ? nc - 1 - (i + u) : (i + u);
        int chg = seq * nc + c;
        ptr[u] = p.st + ((size_t)chg * 32 + combo) * 8192 + v * W;
        L[u] = *(const hv*)ptr[u];
        d[u] = p.dec[chg * 32 + combo];
      }
#pragma unroll
      for (int u = 0; u < 8; ++u) {
        hv o;
#pragma unroll
        for (int j = 0; j < W; ++j) { o[j] = (h16)carry[j]; carry[j] = carry[j] * d[u] + (float)L[u][j]; }
        if (!dry) *(hv*)ptr[u] = o;
      }
    }
  }
}
__device__ void phase_ssd_scan(const Params& p, int g, int dry) {
  CTX;
  if (g < 2) ssd_scan_body<8>(p, g, dry, TIDX, BIDX);
  else ssd_scan_body<4>(p, g, dry, TIDX, BIDX);
}

__device__ void phase_ssd_out(const Params& p, int g, int l, char* shm, int dry) {
  CTX;
  const int S = (g < 2) ? 2048 : 8192;
  h16* Cs = (h16*)shm;
  h16* Bs = Cs + 128 * SP;
  h16* Sf = Bs;
  h16* Sb = Bs + 64 * SP;
  h16* XT = Bs + 128 * SP;
  h16* Ms = XT + 64 * SP;
  float* dts = (float*)(Ms + 128 * SP);
  float* cums = dts + 2048;
  float4* cwS = (float4*)(cums + 2048);
  const int wid = TIDX >> 6, lane = TIDX & 63, fr = lane & 15, fq = lane >> 4;
  const float* cw = p.conv_w + (size_t)l * 4608;
  const float* cb = p.conv_b + (size_t)l * 1536;
  for (int item = BIDX; item < 256; item += gridDim.x) {
    const int grp = item & 1, ch = item >> 1, t0 = ch * 128, tl0 = t0 & (S - 1);
#pragma unroll
    for (int i = TIDX; i < 768; i += 512) {
      int c = (i < 128) ? 1024 + grp * 128 + i : (i < 256) ? 1280 + grp * 128 + (i - 128) : grp * 512 + (i - 256);
      cwS[i] = float4{cw[c], cw[1536 + c], cw[3072 + c], cb[c]};
    }
    Raw3 br[4];
#pragma unroll
    for (int k = 0; k < 4; ++k) { const int s = CT_S(k, 4); br[k] = conv_load(XROW(s) + 1024 + grp * 128 + CT_C8(k, 4), HP(s), HN(s)); }
    ssd_dt_cum(p, l, t0, grp, dts, cums, TIDX);
#pragma unroll
    for (int k = 0; k < 4; ++k) {
      float o[8];
      const int s = CT_S(k, 4), c8 = CT_C8(k, 4);
      conv_apply(br[k], cwS + c8, o);
      h16x8 ov;
#pragma unroll
      for (int j = 0; j < 8; ++j) ov[j] = (h16)o[j];
      *(h16x8*)(Bs + s * SP + c8) = ov;
    }
#pragma unroll
    for (int k = 0; k < 4; ++k) { const int s = CT_S(k, 4); br[k] = conv_load(XROW(s) + 1280 + grp * 128 + CT_C8(k, 4), HP(s), HN(s)); }
    Raw3 xr[2];
#pragma unroll
    for (int k = 0; k < 2; ++k) { const int s = CT_S(k, 3); xr[k] = conv_load(XROW(s) + grp * 512 + CT_C8(k, 3), HP(s), HN(s)); }
    const int sc8 = (TIDX & 15) * 8;
    const h16* stb = p.st + (((size_t)ch * 2 + grp) * 2) * 8 * 8192;
#pragma unroll
    for (int k = 0; k < 4; ++k) {
      float o[8];
      const int s = CT_S(k, 4), c8 = CT_C8(k, 4);
      conv_apply(br[k], cwS + 128 + c8, o);
      h16x8 ov;
#pragma unroll
      for (int j = 0; j < 8; ++j) ov[j] = (h16)o[j];
      *(h16x8*)(Cs + s * SP + c8) = ov;
    }
    __syncthreads();
    const int lcol = wid * 16 + fr;
    f32x4 cbT[8];
#pragma unroll
    for (int st = 0; st < 8; ++st) {
      f32x4 acc = {0.f, 0.f, 0.f, 0.f};
#pragma unroll
      for (int ks = 0; ks < 4; ++ks) {
        h16x8 a = *(const h16x8*)(Bs + (st * 16 + fr) * SP + ks * 32 + fq * 8);
        acc = __builtin_amdgcn_mfma_f32_16x16x32_f16(a, *(const h16x8*)(Cs + lcol * SP + ks * 32 + fq * 8), acc, 0, 0, 0);
      }
      cbT[st] = acc;
    }
    float ssq_acc = 0.f;
    h16* zrow = p.proj + (size_t)(t0 + lcol) * LDP + CZ + grp * 512 + 4 * fq;
#pragma unroll 1
    for (int hh = 0; hh < 8; ++hh) {
      __syncthreads();
      h16x8 sfr[4];
#pragma unroll
      for (int k = 0; k < 4; ++k) {
        int task = TIDX + k * 512, which = task >> 10, r = (task >> 4) & 63;
        sfr[k] = *(const h16x8*)(stb + ((size_t)which * 8 + hh) * 8192 + r * 128 + sc8);
      }
#pragma unroll
      for (int k = 0; k < 2; ++k) {
        float o[8];
        const int s = CT_S(k, 3), c8 = CT_C8(k, 3);
        conv_apply(xr[k], cwS + 256 + hh * 64 + c8, o);
#pragma unroll
        for (int j = 0; j < 8; ++j) XT[swz_off(c8 + j, s)] = (h16)o[j];
      }
      h16x4 zv[4];
#pragma unroll
      for (int pt = 0; pt < 4; ++pt) zv[pt] = *(const h16x4*)(zrow + hh * 64 + pt * 16);
      const float cfl = cums[hh * 128 + lcol], cbl = cums[(8 + hh) * 128 + lcol];
#pragma unroll
      for (int st = 0; st < 8; ++st) {
        const int s0 = st * 16 + 4 * fq;
        f32x4 cfs = *(const f32x4*)(cums + hh * 128 + s0), cbs = *(const f32x4*)(cums + (8 + hh) * 128 + s0);
        f32x4 dfs = *(const f32x4*)(dts + hh * 128 + s0), dbs = *(const f32x4*)(dts + (8 + hh) * 128 + s0);
        h16x4 mv;
#pragma unroll
        for (int j = 0; j < 4; ++j) {
          const int s = s0 + j;
          float e = (s <= lcol) ? cfl - cfs[j] : cbl - cbs[j];
          float d = (s <= lcol) ? dfs[j] : dbs[j];
          float v = __expf(e) * d;
          if (s == lcol) v = dfs[j] + dbs[j];
          mv[j] = (h16)(cbT[st][j] * v);
        }
        *(h16x4*)(Ms + lcol * SP + s0) = mv;
      }
#pragma unroll
      for (int k = 0; k < 4; ++k) {
        int task = TIDX + k * 512, which = task >> 10, r = (task >> 4) & 63;
        *(h16x8*)((which ? Sb : Sf) + r * SP + sc8) = sfr[k];
      }
      __syncthreads();
      if (hh < 7) {
#pragma unroll
        for (int k = 0; k < 2; ++k) { const int s = CT_S(k, 3); xr[k] = conv_load(XROW(s) + grp * 512 + (hh + 1) * 64 + CT_C8(k, 3), HP(s), HN(s)); }
      }
      h16x8 mfrag[4];
#pragma unroll
      for (int ks = 0; ks < 4; ++ks) mfrag[ks] = *(const h16x8*)(Ms + lcol * SP + ks * 32 + fq * 8);
      const float ecf = __expf(cfl), ecb = __expf(cbl), Dk = p.d_skip[l * 16 + grp * 8 + hh];
#pragma unroll
      for (int pt = 0; pt < 4; ++pt) {
        f32x4 aY = {0.f, 0.f, 0.f, 0.f}, aF = aY, aB = aY;
#pragma unroll
        for (int ks = 0; ks < 4; ++ks) {
          const int o = (pt * 16 + fr) * SP + ks * 32 + fq * 8;
          aY = __builtin_amdgcn_mfma_f32_16x16x32_f16(*(const h16x8*)(XT + swz_off(pt * 16 + fr, ks * 32 + fq * 8)), mfrag[ks], aY, 0, 0, 0);
          const h16x8 cf = *(const h16x8*)(Cs + lcol * SP + ks * 32 + fq * 8);
          aF = __builtin_amdgcn_mfma_f32_16x16x32_f16(*(const h16x8*)(Sf + o), cf, aF, 0, 0, 0);
          aB = __builtin_amdgcn_mfma_f32_16x16x32_f16(*(const h16x8*)(Sb + o), cf, aB, 0, 0, 0);
        }
        const int p0 = pt * 16 + 4 * fq;
        h16x4 ov;
#pragma unroll
        for (int j = 0; j < 4; ++j) {
          float x = (float)XT[swz_off(p0 + j, lcol)];
          float y = aY[j] + ecf * aF[j] + ecb * aB[j] + Dk * x;
          float gt = y * silu_f((float)zv[pt][j]);
          ssq_acc += gt * gt;
          ov[j] = (h16)gt;
        }
        if (!dry) *(h16x4*)(zrow + hh * 64 + pt * 16) = ov;
      }
    }
    ssq_acc += __shfl_xor(ssq_acc, 16, 64);
    ssq_acc += __shfl_xor(ssq_acc, 32, 64);
    if (fq == 0 && !dry) p.ssq[(size_t)(t0 + lcol) * 2 + grp] = ssq_acc;
    __syncthreads();
  }
}

#define XB_TMO 128
#define XB_XCNT(j) (256 + 64 * (j))
#define XB_XSUB(j) (1280 + 64 * (j))
#define XB_XGEN(j) (2304 + 64 * (j))
#define XB_TOP 3328
#define XB_TOPGEN 3392
#define XCD_BAR_WORDS 3456
#define XB_SPIN_CAP (1u << 20)
__device__ __forceinline__ unsigned xb_ld(unsigned* p) { return __hip_atomic_load(p, __ATOMIC_RELAXED, __HIP_MEMORY_SCOPE_AGENT); }
__device__ __forceinline__ unsigned xb_add(unsigned* p, unsigned v) { return __hip_atomic_fetch_add(p, v, __ATOMIC_RELAXED, __HIP_MEMORY_SCOPE_AGENT); }
__device__ __forceinline__ unsigned xb_xcc_id() { return (unsigned)__builtin_amdgcn_s_getreg((3 << 11) | 20) & 0xFu; }
#define XB_SPIN(cond, bar)                                                                        \
  do {                                                                                            \
    unsigned _sp = 0;                                                                             \
    while (cond) {                                                                                \
      __builtin_amdgcn_s_sleep(1);                                                                \
      if ((++_sp & 255u) == 0u) {                                                                 \
        if (xb_ld(&(bar)[XB_TMO])) break;                                                         \
        if (_sp > XB_SPIN_CAP) { atomicAdd(&(bar)[XB_TMO], 1u); break; }                          \
      }                                                                                           \
    }                                                                                             \
  } while (0)
__device__ __forceinline__ void xcd_barrier_complete(unsigned* bar, unsigned x, unsigned& nloc, unsigned& nx) {
  const unsigned G = gridDim.x;
  unsigned sum, cnt, mine, sp = 0u;
  for (;;) {
    sum = 0u; cnt = 0u; mine = 0u;
#pragma unroll
    for (unsigned j = 0; j < 16; ++j) { const unsigned c = xb_ld(&bar[XB_XCNT(j)]); sum += c; cnt += (c > 0u) ? 1u : 0u; mine = (j == x) ? c : mine; }
    if (sum == G) break;
    __builtin_amdgcn_s_sleep(1);
    if ((++sp & 255u) == 0u) { if (xb_ld(&bar[XB_TMO])) break; if (sp > XB_SPIN_CAP) { atomicAdd(&bar[XB_TMO], 1u); break; } }
  }
  nloc = mine > 0u ? mine : 1u; nx = cnt > 0u ? cnt : 1u;
}
__device__ __forceinline__ void xcd_barrier(unsigned* bar, unsigned x, volatile LAS unsigned* st) {
  asm volatile("s_waitcnt vmcnt(0)" ::: "memory");
  __syncthreads();
  if (threadIdx.x == 0) {
    __builtin_amdgcn_s_waitcnt(0);
    unsigned nloc = st[0], nx = st[1];
    if (nloc == 0u) { xcd_barrier_complete(bar, x, nloc, nx); st[0] = nloc; st[1] = nx; }
    const unsigned old = xb_add(&bar[XB_XSUB(x)], 1u);
    const unsigned gen = old / nloc;
    if (old + 1u == (gen + 1u) * nloc) {
      __builtin_amdgcn_fence(__ATOMIC_RELEASE, "agent");
      asm volatile("s_waitcnt vmcnt(0)" ::: "memory");
      const unsigned og = xb_add(&bar[XB_TOP], 1u);
      const unsigned tg = og / nx;
      if (og + 1u == (tg + 1u) * nx) xb_add(&bar[XB_TOPGEN], 1u);
      else XB_SPIN(xb_ld(&bar[XB_TOPGEN]) == tg, bar);
      __builtin_amdgcn_fence(__ATOMIC_ACQUIRE, "agent");
      xb_add(&bar[XB_XGEN(x)], 1u);
      asm volatile("s_waitcnt vmcnt(0)" ::: "memory");
    } else {
      XB_SPIN(xb_ld(&bar[XB_XGEN(x)]) == gen, bar);
      __builtin_amdgcn_fence(__ATOMIC_ACQUIRE, "agent");
      asm volatile("s_waitcnt vmcnt(0)" ::: "memory");
    }
  }
  __syncthreads();
}

__device__ __forceinline__ unsigned long long rd_tab(const unsigned* tab, int i) {
  unsigned lo = __builtin_amdgcn_readfirstlane(tab[2 * i]), hi = __builtin_amdgcn_readfirstlane(tab[2 * i + 1]);
  return ((unsigned long long)hi << 32) | lo;
}
template <class T> __device__ __forceinline__ T* as_global(unsigned long long v) {
  return (T*)(__attribute__((address_space(1))) T*)v;
}
__device__ __forceinline__ Params load_params(const unsigned* tab) {
  Params q;
#define X(i, T, n) q.n = as_global<std::remove_pointer_t<T>>(rd_tab(tab, i));
  PFIELDS(X)
#undef X
  q.step_lo = 0; q.step_hi = 0;
  return q;
}
#define LP const Params p = load_params(tab)
__device__ void run_step(const unsigned* tab, int s, char* shm) {
  if (s == 0) { { LP; phase_prep(p, shm); } { LP; phase_pre(p, 0); } return; }
  s -= 1;
  const int g = s >> 5, r = s & 31;
  const int l = r >> 3, ph = r & 7;
  switch (ph) {
    case 0: { LP; phase_inproj(p, l, shm); } break;
    case 1:
      if (blockIdx.x & 1) { { LP; phase_gmlp(p, l, shm, 0); } { LP; phase_ssd_state(p, g, l, shm); } }
      else { { LP; phase_ssd_state(p, g, l, shm); } { LP; phase_gmlp(p, l, shm, 0); } }
      break;
    case 2:
      if (blockIdx.x & 1) { { LP; phase_attn(p, g, l, shm, 0); } { LP; phase_ssd_scan(p, g, 0); } }
      else { { LP; phase_ssd_scan(p, g, 0); } { LP; phase_attn(p, g, l, shm, 0); } }
      break;
    case 3: { LP; phase_ssd_out(p, g, l, shm, 0); } break;
    case 4: { LP; phase_merge(p, l, shm); } break;
    case 5: { LP; phase_wout(p, g, l, shm); } break;
    case 6: { LP; phase_ff1(p, l, shm); } break;
    default: { { LP; phase_ff2(p, g, l, shm); } if (l == NLAYER - 1 && g < 2) { LP; phase_pre(p, g + 1); } } break;
  }
}

__global__ void __launch_bounds__(512, 2) mega(Params p) {
  extern __shared__ __attribute__((aligned(16))) char shm[];
  unsigned long long* tab = (unsigned long long*)(shm + SHM_TAB);
  volatile LAS unsigned* bst = (volatile LAS unsigned*)(LAS unsigned*)(shm + SHM_TAB - 16);
  if (threadIdx.x == 0) {
#define X(i, T, n) tab[i] = (unsigned long long)p.n;
    PFIELDS(X)
#undef X
    bst[0] = 0u; bst[1] = 0u;
  }
  const int lo = p.step_lo, hi = p.step_hi;
  unsigned* bar = p.bar;
  const unsigned xcc = xb_xcc_id();
  __syncthreads();
  if (threadIdx.x == 0) (void)xb_add(&bar[XB_XCNT(xcc)], 1u);
  for (int s = lo; s < hi; ++s) {
    if (s > lo) {
      if (s == lo + 1) cg::this_grid().sync();
      else xcd_barrier(as_global<unsigned>(rd_tab((const unsigned*)tab, 36)), xcc, bst);
    }
    run_step((const unsigned*)tab, s, shm);
  }
}

extern "C" void kernel_launch(void* const* d_in, const int* in_sizes, int n_in, void* d_out, int out_size, void* d_ws,
                              size_t ws_size, hipStream_t stream) {
  Params p{};
  {
    const float** fp = (const float**)&p;
    for (int i = 0; i < 25; ++i) fp[i] = (const float*)d_in[i];
  }
  p.out = (float*)d_out;
  char* ws = (char*)d_ws;
  size_t off = 0;
  p.wt = (h16*)(ws + off); off += (size_t)NLAYER * WL * 2;
  p.proj = (h16*)(ws + off); off += (size_t)TG * LDP * 2;
  p.bufA = (h16*)(ws + off); off += (size_t)TG * 1024 * 2;
  p.bufB = (h16*)(ws + off); off += (size_t)TG * 1024 * 2;
  p.st = (h16*)(ws + off); off += (size_t)64 << 20;
  p.rssX = (float*)(ws + off); off += (size_t)TG * 4;
  p.rssH = (float*)(ws + off); off += (size_t)TG * 4;
  p.dtbuf = (float*)(ws + off); off += (size_t)TG * 32 * 4;
  p.dec = (float*)(ws + off); off += (size_t)128 * 32 * 4;
  p.ssq = (float*)(ws + off); off += (size_t)TG * 2 * 4;
  p.bar = (unsigned*)(ws + off); off += (size_t)XCD_BAR_WORDS * 4;
  static int grid_blocks = 0;
  if (!grid_blocks) {
    (void)hipFuncSetAttribute((const void*)mega, hipFuncAttributeMaxDynamicSharedMemorySize, SHM_TOTAL);
    int dev = 0, cus = 0, per_cu = 0;
    (void)hipGetDevice(&dev);
    (void)hipDeviceGetAttribute(&cus, hipDeviceAttributeMultiprocessorCount, dev);
    (void)hipOccupancyMaxActiveBlocksPerMultiprocessor(&per_cu, mega, 512, SHM_TOTAL);
    grid_blocks = cus * per_cu;
    if (grid_blocks > 256 || grid_blocks <= 0) grid_blocks = 256;
  }
  (void)hipMemsetAsync(p.bar, 0, (size_t)XCD_BAR_WORDS * 4, stream);
#if MULTI_LAUNCH
  for (int s = 0; s < NSTEPS; ++s) {
    p.step_lo = s;
    p.step_hi = s + 1;
    hipLaunchKernelGGL(mega, dim3(grid_blocks), dim3(512), SHM_TOTAL, stream, p);
  }
#else
  p.step_lo = 0;
  p.step_hi = NSTEPS;
  void* args[] = {&p};
  (void)hipLaunchCooperativeKernel((void*)mega, dim3(grid_blocks), dim3(512), args, SHM_TOTAL, stream);
#endif
}
```

```cpp
#include <hip/hip_runtime.h>
#include <hip/hip_fp16.h>
#include <hip/hip_cooperative_groups.h>
#include <type_traits>
namespace cg = cooperative_groups;

#ifndef MULTI_LAUNCH
#define MULTI_LAUNCH 0
#endif

typedef _Float16 h16;
using h16x8 = __attribute__((ext_vector_type(8))) _Float16;
using h16x4 = __attribute__((ext_vector_type(4))) _Float16;
using h16x2 = __attribute__((ext_vector_type(2))) _Float16;
using f32x4 = __attribute__((ext_vector_type(4))) float;

constexpr int LDP = 7456, TG = 16384, NLAYER = 4, LDH = 4160;
constexpr int CQ = 0, CK = 512, CV = 640, CGU = 768, CGV = 1280, CZ = 1792, CX = 2816, CDT = 4352, CG = 4384;
constexpr float EPS = 1e-6f;
constexpr long O_WIN = 0, O_UPA = 7456L * 1024, O_UPB = O_UPA + 524288, O_UPC = O_UPB + 524288, O_WOUT = O_UPC + 1048576,
               O_FF1 = O_WOUT + 1048576, O_FF2 = O_FF1 + 4194304, O_WSP = O_FF2 + 1024L * LDH, WL = O_WSP + 65536;
constexpr int SHM_GEMM = 131072, SHM_TOTAL = 163840, SHM_TAB = 162816;
constexpr int NSTEPS = 1 + 3 * 32;

#define PFIELDS(X)                                                                                                         \
  X(0, const float*, x_prompt) X(1, const float*, x_sample) X(2, const float*, rel_bias) X(3, const float*, norm_mix_g)    \
  X(4, const float*, w_in) X(5, const float*, q_norm_g) X(6, const float*, k_norm_g) X(7, const float*, attn_sink)         \
  X(8, const float*, gmlp_ln_g) X(9, const float*, gmlp_ln_b) X(10, const float*, w_spatial) X(11, const float*, b_spatial) \
  X(12, const float*, conv_w) X(13, const float*, conv_b) X(14, const float*, dt_bias) X(15, const float*, a_log)          \
  X(16, const float*, d_skip) X(17, const float*, ssd_norm_g) X(18, const float*, w_up_attn) X(19, const float*, w_up_gmlp) \
  X(20, const float*, w_up_ssd) X(21, const float*, w_out) X(22, const float*, norm_ff_g) X(23, const float*, w_ff1)       \
  X(24, const float*, w_ff2) X(25, float*, out) X(26, h16*, wt) X(27, h16*, proj) X(28, h16*, bufA) X(29, h16*, bufB)      \
  X(30, h16*, st) X(31, float*, rssX) X(32, float*, rssH) X(33, float*, dtbuf) X(34, float*, dec) X(35, float*, ssq) X(36, unsigned*, bar)
struct Params {
#define X(i, T, n) T n;
  PFIELDS(X)
#undef X
  int step_lo, step_hi;
};

__device__ __forceinline__ float wave_sum(float v) {
#pragma unroll
  for (int o = 32; o > 0; o >>= 1) v += __shfl_xor(v, o, 64);
  return v;
}
__device__ __forceinline__ float gelu_t(float x) {
  float u2 = 1.5957691216057308f * (x + 0.044715f * x * x * x);
  return x * __builtin_amdgcn_rcpf(1.f + __expf(-u2));
}
__device__ __forceinline__ float silu_f(float x) { return x * __builtin_amdgcn_rcpf(1.f + __expf(-x)); }
__device__ __forceinline__ float clampf(float x, float lo, float hi) { return fminf(fmaxf(x, lo), hi); }

__device__ __forceinline__ int opaque_tid() { int t = threadIdx.x; asm volatile("" : "+v"(t)); return t; }
__device__ __forceinline__ int opaque_bid() { int b = blockIdx.x; asm volatile("" : "+s"(b)); return b; }
#define CTX const int TIDX = opaque_tid(); const int BIDX = opaque_bid(); (void)TIDX; (void)BIDX

__device__ void prep_tile(const float* __restrict__ src, int K, int N, h16* __restrict__ dst, const float* __restrict__ scale,
                          int nt, int kt, char* shm, int ldd = 0) {
  CTX;
  float(*tile)[65] = (float(*)[65])shm;
  const int tid = TIDX;
  const int n0 = nt * 64, k0 = kt * 64;
  {
    int nn = tid & 63, kk0 = tid >> 6;
#pragma unroll
    for (int i = 0; i < 8; ++i) {
      int kk = kk0 + 8 * i;
      float v = 0.f;
      if (n0 + nn < N) {
        v = src[(size_t)(k0 + kk) * N + n0 + nn];
        if (scale) v *= scale[k0 + kk];
      }
      tile[kk][nn] = v;
    }
  }
  __syncthreads();
  {
    int kk = tid & 63, nn0 = tid >> 6;
#pragma unroll
    for (int i = 0; i < 8; ++i) {
      int nn = nn0 + 8 * i;
      if (n0 + nn < N) dst[(size_t)(n0 + nn) * (ldd ? ldd : K) + k0 + kk] = (h16)tile[kk][nn];
    }
  }
  __syncthreads();
}

__device__ void phase_prep(const Params& p, char* shm, int l_lo, int l_hi) {
  CTX;
  constexpr int T_IN = 117 * 16, T_UA = 16 * 8, T_UC = 16 * 16, T_F = 64 * 16, T_SP = 16;
  constexpr int PER = T_IN + 2 * T_UA + 2 * T_UC + 2 * T_F + T_SP;
  for (int item = BIDX; item < PER * (l_hi - l_lo); item += gridDim.x) {
    int l = l_lo + item / PER, r = item % PER;
    h16* wl = p.wt + (size_t)l * WL;
    if (r < T_IN) { prep_tile(p.w_in + (size_t)l * 1024 * LDP, 1024, LDP, wl + O_WIN, p.norm_mix_g + l * 1024, r / 16, r % 16, shm); continue; }
    r -= T_IN;
    if (r < T_UA) { prep_tile(p.w_up_attn + (size_t)l * 512 * 1024, 512, 1024, wl + O_UPA, nullptr, r / 8, r % 8, shm); continue; }
    r -= T_UA;
    if (r < T_UA) { prep_tile(p.w_up_gmlp + (size_t)l * 512 * 1024, 512, 1024, wl + O_UPB, nullptr, r / 8, r % 8, shm); continue; }
    r -= T_UA;
    if (r < T_UC) { int hf = r >> 7, rr = r & 127; prep_tile(p.w_up_ssd + (size_t)l * 1024 * 1024 + (size_t)hf * 512 * 1024, 512, 1024, wl + O_UPC + hf * 524288, p.ssd_norm_g + l * 1024 + hf * 512, rr / 8, rr % 8, shm); continue; }
    r -= T_UC;
    if (r < T_UC) { prep_tile(p.w_out + (size_t)l * 1024 * 1024, 1024, 1024, wl + O_WOUT, nullptr, r / 16, r % 16, shm); continue; }
    r -= T_UC;
    if (r < T_F) { prep_tile(p.w_ff1 + (size_t)l * 1024 * 4096, 1024, 4096, wl + O_FF1, p.norm_ff_g + l * 1024, r / 16, r % 16, shm); continue; }
    r -= T_F;
    if (r < T_F) { prep_tile(p.w_ff2 + (size_t)l * 4096 * 1024, 4096, 1024, wl + O_FF2, nullptr, r / 64, r % 64, shm, LDH); continue; }
    r -= T_F;
    {
      const float* s = p.w_spatial + (size_t)l * 65536 + r * 4096;
      h16* d = wl + O_WSP + r * 4096;
      for (int i = TIDX; i < 4096; i += 512) d[i] = (h16)s[i];
    }
  }
}

__device__ void phase_pre(const Params& p, int g) {
  CTX;
  const float* xin = (g < 2) ? p.x_prompt + (size_t)g * TG * 1024 : p.x_sample;
  float* xo = p.out + (size_t)g * TG * 1024;
  const int wid = TIDX >> 6, lane = TIDX & 63;
  for (int row = BIDX * 8 + wid; row < TG; row += gridDim.x * 8) {
    const float4* s4 = (const float4*)(xin + (size_t)row * 1024);
    float4* d4 = (float4*)(xo + (size_t)row * 1024);
    float ss = 0.f;
#pragma unroll
    for (int i = 0; i < 4; ++i) {
      int idx = i * 64 + lane;
      float4 v = s4[idx];
      d4[idx] = v;
      ss += v.x * v.x + v.y * v.y + v.z * v.z + v.w * v.w;
      h16x4 hv = {(h16)v.x, (h16)v.y, (h16)v.z, (h16)v.w};
      *(h16x4*)(p.bufA + (size_t)row * 1024 + idx * 4) = hv;
    }
    ss = wave_sum(ss);
    if (lane == 0) p.rssX[row] = ss;
  }
}

#define LAS __attribute__((address_space(3)))
constexpr int BK = 64, HALF = 128, HTB = HALF * BK * 2;
__device__ __forceinline__ int lds_byte(int r, int c) {
  const int st = (r >> 4) * 2 + (c >> 5), rr = r & 15, cc = c & 31, ob = rr * 64 + cc * 2;
  return st * 1024 + (ob ^ (((ob >> 9) & 1) << 5));
}
__device__ __forceinline__ void stage_rc(int b, int& R, int& C) {
  const int st = b / 1024, sb = b % 1024, swz = sb ^ (((sb >> 9) & 1) << 5);
  R = (st >> 1) * 16 + swz / 64;
  C = (st & 1) * 32 + (swz % 64) / 2;
}
__device__ __forceinline__ int perm32(int rho) { const int n = rho >> 4, i = rho & 15; return 8 * (i >> 2) + 4 * n + (i & 3); }

struct Unit { const char* A; const char* B; int pm, pn, seg; };

__device__ __forceinline__ void tile_map(int t, int total, int nN, int& pm, int& pn) {
  int base = t & ~255, i = t & 255;
  int R = min(256, total - base);
  int id = (R & 7) ? t : base + (i & 7) * (R >> 3) + (i >> 3);
  int band = id / (8 * nN), w = id % (8 * nN);
  pm = band * 8 + (w & 7);
  pn = w >> 3;
}

template <class Sched, class Epi>
__device__ __forceinline__ void gemm_phase(LAS unsigned char* lds, const int lda, const int ldb, const int nt, const Sched& S, const Epi& E) {
  CTX;
  const int tid = TIDX, wid = __builtin_amdgcn_readfirstlane(tid >> 6), lane = tid & 63, wr = wid >> 2, wc = wid & 3, fr = lane & 15, fq = lane >> 4;
  unsigned voffA[2], voffB[2];
#pragma unroll
  for (int i = 0; i < 2; ++i) {
    int R, C;
    stage_rc(tid * 16 + i * 8192, R, C);
    const int Rb = (R & ~31) + perm32(R & 31);
    voffA[i] = (unsigned)(R * lda + C) * 2u;
    voffB[i] = (unsigned)(Rb * ldb + C) * 2u;
  }
  const size_t kstep = (size_t)(BK * 2);
  const size_t hstepA = (size_t)HALF * lda * 2, hstepB = (size_t)HALF * ldb * 2;
  const unsigned ldsw = (unsigned)wid * 1024u;
  const int aoff = lds_byte(wr * 64 + fr, fq * 8), boff = lds_byte(wc * 32 + fr, fq * 8);
#define G_SA(b, h) (((b)*2 + (h)) * HTB)
#define G_SB(b, h) ((4 + (b)*2 + (h)) * HTB)
#define G_STAGE(bufoff, gbase, voff)                                                                                        \
  do {                                                                                                                      \
    _Pragma("unroll") for (int _i = 0; _i < 2; ++_i) __builtin_amdgcn_global_load_lds(                                      \
        (const unsigned*)((const char*)(gbase) + (voff)[_i]), (LAS unsigned*)(lds + (bufoff) + ldsw + _i * 8192), 16, 0, 0); \
  } while (0)
#define G_LDA(dst, b, h)                                                                                                    \
  do {                                                                                                                      \
    _Pragma("unroll") for (int m = 0; m < 4; ++m) _Pragma("unroll") for (int k = 0; k < 2; ++k) dst[m][k] =                 \
        *(const LAS h16x8*)(lds + G_SA(b, h) + aoff + m * 2048 + k * 1024);                                                 \
  } while (0)
#define G_LDB(dst, b, h)                                                                                                    \
  do {                                                                                                                      \
    _Pragma("unroll") for (int n = 0; n < 2; ++n) _Pragma("unroll") for (int k = 0; k < 2; ++k) dst[n][k] =                 \
        *(const LAS h16x8*)(lds + G_SB(b, h) + boff + n * 2048 + k * 1024);                                                 \
  } while (0)
#define G_MMA(ai, bj, At_, Bt_)                                                                                             \
  do {                                                                                                                      \
    __builtin_amdgcn_s_setprio(1);                                                                                          \
    _Pragma("unroll") for (int m = 0; m < 4; ++m) _Pragma("unroll") for (int n = 0; n < 2; ++n)                             \
    _Pragma("unroll") for (int k = 0; k < 2; ++k) acc[ai][bj][m][n] =                                                       \
        __builtin_amdgcn_mfma_f32_16x16x32_f16(Bt_[n][k], At_[m][k], acc[ai][bj][m][n], 0, 0, 0);                           \
    __builtin_amdgcn_s_setprio(0);                                                                                          \
  } while (0)
#define G_WAIT_V(n) asm volatile("s_waitcnt vmcnt(" #n ")" ::: "memory")
#define G_WAIT_L(n) asm volatile("s_waitcnt lgkmcnt(" #n ")" ::: "memory")
#define G_BAR __builtin_amdgcn_s_barrier()
#define G_SCHED __builtin_amdgcn_sched_barrier(0)
#define G_ZERO                                                                                       \
  _Pragma("unroll") for (int a = 0; a < 2; ++a) _Pragma("unroll") for (int b = 0; b < 2; ++b)        \
  _Pragma("unroll") for (int m = 0; m < 4; ++m) _Pragma("unroll") for (int n = 0; n < 2; ++n) acc[a][b][m][n] = f32x4{0.f, 0.f, 0.f, 0.f}
  Unit cur, nxt;
  int ui = 0;
  if (!S.next(0, cur)) return;
  f32x4 acc[2][2][4][2];
  G_ZERO;
  h16x8 At[4][2], B0[2][2], B1[2][2];
  const char* cA = cur.A;
  const char* cB = cur.B;
  G_STAGE(G_SB(0, 0), cB, voffB); G_STAGE(G_SA(0, 0), cA, voffA); G_STAGE(G_SB(0, 1), cB + hstepB, voffB); G_STAGE(G_SA(0, 1), cA + hstepA, voffA);
  if (wr == 1) G_BAR;
  G_WAIT_V(4); G_BAR;
  G_STAGE(G_SB(1, 0), cB + kstep, voffB); G_STAGE(G_SA(1, 0), cA + kstep, voffA); G_STAGE(G_SB(1, 1), cB + hstepB + kstep, voffB);
  G_WAIT_V(6); G_BAR;
  for (;;) {
    const typename Epi::Pre pre = E.prefetch(cur, wr, fr);
    const bool has_next = S.next(ui + 1, nxt);
    const char* nA = has_next ? nxt.A : cA;
    const char* nB = has_next ? nxt.B : cB;
    for (int t = 0; t < nt; t += 2) {
      const bool last = (t == nt - 2);
      const char* a1 = cA + (size_t)(t + 1) * kstep;
      const char* a2 = last ? nA : cA + (size_t)(t + 2) * kstep;
      const char* b2 = last ? nB : cB + (size_t)(t + 2) * kstep;
      const char* a3 = a2 + kstep;
      const char* b3 = b2 + kstep;
      G_LDB(B0, 0, 0); G_SCHED; G_LDA(At, 0, 0); G_STAGE(G_SA(1, 1), a1 + hstepA, voffA);
      G_WAIT_L(8); G_BAR; G_WAIT_L(0); G_MMA(0, 0, At, B0); G_BAR; G_SCHED;
      G_LDB(B1, 0, 1); G_STAGE(G_SB(0, 0), b2, voffB);
      G_BAR; G_WAIT_L(0); G_MMA(0, 1, At, B1); G_BAR;
      G_LDA(At, 0, 1); G_STAGE(G_SA(0, 0), a2, voffA);
      G_BAR; G_WAIT_L(0); G_MMA(1, 0, At, B0); G_BAR; G_SCHED;
      G_STAGE(G_SB(0, 1), b2 + hstepB, voffB);
      G_WAIT_V(6); G_BAR; G_MMA(1, 1, At, B1); G_BAR;
      G_LDB(B0, 1, 0); G_SCHED; G_LDA(At, 1, 0); G_STAGE(G_SA(0, 1), a2 + hstepA, voffA);
      G_WAIT_L(8); G_BAR; G_WAIT_L(0); G_MMA(0, 0, At, B0); G_BAR; G_SCHED;
      G_LDB(B1, 1, 1); G_STAGE(G_SB(1, 0), b3, voffB);
      G_BAR; G_WAIT_L(0); G_MMA(0, 1, At, B1); G_BAR;
      G_LDA(At, 1, 1); G_STAGE(G_SA(1, 0), a3, voffA);
      G_BAR; G_WAIT_L(0); G_MMA(1, 0, At, B0); G_BAR; G_SCHED;
      G_STAGE(G_SB(1, 1), b3 + hstepB, voffB);
      G_WAIT_V(6); G_BAR; G_MMA(1, 1, At, B1); G_BAR;
    }
    int fr_o = fr, fq_o = fq;
    asm volatile("" : "+v"(fr_o), "+v"(fq_o));
    const bool clr = E(acc, cur, pre, wr, wc, fr_o, fq_o);
    if (!has_next) break;
    if (clr) { G_ZERO; }
    cur = nxt; cA = nA; cB = nB; ++ui;
  }
  G_WAIT_V(0);
  if (wr == 0) G_BAR;
  G_BAR;
}

struct SchedTiles {
  const char *A, *B; size_t tstepA, tstepB; int nN, total, G, c;
  __device__ __forceinline__ bool next(int i, Unit& u) const {
    const long L = (long)i * G + c;
    if (L >= total) return false;
    tile_map((int)L, total, nN, u.pm, u.pn);
    u.A = A + (size_t)u.pm * tstepA; u.B = B + (size_t)u.pn * tstepB; u.seg = 0;
    return true;
  }
};
struct SchedMerge {
  const char *proj, *wl; int G, c;
  __device__ __forceinline__ bool next(int i, Unit& u) const {
    const int tile = (i >> 2) * G + c;
    if (tile >= 256) return false;
    const int seg = i & 3;
    tile_map(tile, 256, 4, u.pm, u.pn);
    const int acol = seg == 0 ? CQ : seg == 1 ? CGU : seg == 2 ? CZ : CZ + 512;
    const long bo = seg == 0 ? O_UPA : seg == 1 ? O_UPB : seg == 2 ? O_UPC : O_UPC + 524288;
    u.A = proj + ((size_t)u.pm * 256 * LDP + acol) * 2;
    u.B = wl + ((size_t)bo + (size_t)u.pn * 256 * 512) * 2;
    u.seg = seg;
    return true;
  }
};

#define FOR_ROWS _Pragma("unroll") for (int ai = 0; ai < 2; ++ai) _Pragma("unroll") for (int m = 0; m < 4; ++m)
__device__ __forceinline__ h16x8 pack8(f32x4 a, f32x4 b) {
  h16x8 r = {(h16)a[0], (h16)a[1], (h16)a[2], (h16)a[3], (h16)b[0], (h16)b[1], (h16)b[2], (h16)b[3]};
  return r;
}

struct EpiInproj {
  h16* proj; float* dtbuf; const float* rss;
  struct Pre { float v[8]; };
  __device__ __forceinline__ Pre prefetch(const Unit& u, int wr, int fr) const {
    Pre q;
    const int row0 = u.pm * 256 + wr * 64 + fr;
#pragma unroll
    for (int r8 = 0; r8 < 8; ++r8) q.v[r8] = rss[row0 + (r8 >> 2) * 128 + (r8 & 3) * 16];
    return q;
  }
  __device__ __forceinline__ bool operator()(f32x4 (&acc)[2][2][4][2], const Unit& u, const Pre& pre, int wr, int wc, int fr, int fq) const {
    const int row0 = u.pm * 256 + wr * 64 + fr, col0 = u.pn * 256 + wc * 32 + 8 * fq;
    FOR_ROWS {
      const size_t row = row0 + ai * 128 + m * 16;
      const float rs = rsqrtf(pre.v[ai * 4 + m] * (1.f / 1024.f) + EPS);
      h16* rp = proj + row * LDP + col0;
#pragma unroll
      for (int bj = 0; bj < 2; ++bj) {
        const int col = col0 + bj * 128;
        if (col < LDP) {
          f32x4 v0 = acc[ai][bj][m][0] * rs, v1 = acc[ai][bj][m][1] * rs;
          if (col >= CG) {
#pragma unroll
            for (int j = 0; j < 4; ++j) {
              v0[j] = fmaxf(__builtin_amdgcn_rcpf(1.f + __expf(-v0[j])), 6.2e-5f);
              v1[j] = fmaxf(__builtin_amdgcn_rcpf(1.f + __expf(-v1[j])), 6.2e-5f);
            }
          }
          *(h16x8*)(rp + bj * 128) = pack8(v0, v1);
          if (col >= CDT && col < CDT + 32) {
            *(f32x4*)(dtbuf + row * 32 + (col - CDT)) = v0;
            *(f32x4*)(dtbuf + row * 32 + (col - CDT) + 4) = v1;
          }
        }
      }
    }
    return true;
  }
};

__device__ __forceinline__ float sig_ratio(float a, float b) {
  a = clampf(a, -30.f, 30.f);
  b = clampf(b, -30.f, 30.f);
  return (1.f + __expf(-b)) / (1.f + __expf(-a));
}
struct EpiMerge {
  const h16* proj; h16* dst; const float* ssq;
  struct Pre {};
  __device__ __forceinline__ Pre prefetch(const Unit&, int, int) const { return Pre{}; }
  __device__ __forceinline__ bool operator()(f32x4 (&acc)[2][2][4][2], const Unit& u, const Pre& pre, int wr, int wc, int fr, int fq) const {
    const int row0 = u.pm * 256 + wr * 64 + fr, col0 = u.pn * 256 + wc * 32 + 8 * fq;
    const int seg = u.seg;
    const int go = (seg == 3) ? 2048 : seg * 1024;
    const h16x8 one = {1, 1, 1, 1, 1, 1, 1, 1};
    float2 sq[8];
#pragma unroll
    for (int r8 = 0; r8 < 8; ++r8) sq[r8] = *(const float2*)(ssq + (size_t)(row0 + (r8 >> 2) * 128 + (r8 & 3) * 16) * 2);
    h16x8 c0[2] = {one, one}, c1[2] = {one, one}, n0[2] = {one, one}, n1[2] = {one, one};
    {
      const h16* gp = proj + (size_t)row0 * LDP + CG + col0 + go;
      if (seg != 2) { c0[0] = *(const h16x8*)gp; c0[1] = *(const h16x8*)(gp + 128); }
      if (seg < 2) { c1[0] = *(const h16x8*)(gp + 1024); c1[1] = *(const h16x8*)(gp + 1024 + 128); }
    }
#pragma unroll
    for (int r8 = 0; r8 < 8; ++r8) {
      const int ai = r8 >> 2, m = r8 & 3;
      const size_t row = row0 + ai * 128 + m * 16;
      if (r8 < 7) {
        const h16* gp = proj + (size_t)(row0 + ((r8 + 1) >> 2) * 128 + ((r8 + 1) & 3) * 16) * LDP + CG + col0 + go;
        if (seg != 2) { n0[0] = *(const h16x8*)gp; n0[1] = *(const h16x8*)(gp + 128); }
        if (seg < 2) { n1[0] = *(const h16x8*)(gp + 1024); n1[1] = *(const h16x8*)(gp + 1024 + 128); }
      }
      const float q0 = sq[r8].x * (1.f / 512.f) + EPS, q1 = sq[r8].y * (1.f / 512.f) + EPS;
      const float f = (seg == 0) ? 1.f : (seg == 1) ? sqrtf(q0) : (seg == 2) ? rsqrtf(q0) * sqrtf(q1) : rsqrtf(q1);
#pragma unroll
      for (int bj = 0; bj < 2; ++bj) {
#pragma unroll
        for (int j = 0; j < 4; ++j) {
          acc[ai][bj][m][0][j] *= (float)c0[bj][j] * __builtin_amdgcn_rcpf((float)c1[bj][j]) * f;
          acc[ai][bj][m][1][j] *= (float)c0[bj][4 + j] * __builtin_amdgcn_rcpf((float)c1[bj][4 + j]) * f;
        }
        if (seg == 3) *(h16x8*)(dst + row * 1024 + col0 + bj * 128) = pack8(acc[ai][bj][m][0], acc[ai][bj][m][1]);
      }
#pragma unroll
      for (int k = 0; k < 2; ++k) { c0[k] = n0[k]; c1[k] = n1[k]; }
    }
    return seg == 3;
  }
};

struct EpiResid {
  float* xo; h16* copy; float* rss; int feed;
  struct Pre {};
  __device__ __forceinline__ Pre prefetch(const Unit&, int, int) const { return Pre{}; }
  __device__ __forceinline__ bool operator()(f32x4 (&acc)[2][2][4][2], const Unit& u, const Pre& pre, int wr, int wc, int fr, int fq) const {
    const int row0 = u.pm * 256 + wr * 64 + fr, col0 = u.pn * 256 + wc * 32 + 8 * fq;
    f32x4 cur[4], nxt[4];
    {
      const float* xp = xo + (size_t)row0 * 1024 + col0;
      cur[0] = *(const f32x4*)xp; cur[1] = *(const f32x4*)(xp + 4); cur[2] = *(const f32x4*)(xp + 128); cur[3] = *(const f32x4*)(xp + 132);
    }
#pragma unroll
    for (int r8 = 0; r8 < 8; ++r8) {
      const int ai = r8 >> 2, m = r8 & 3;
      const size_t row = row0 + ai * 128 + m * 16;
      if (r8 < 7) {
        const float* xp = xo + (size_t)(row0 + ((r8 + 1) >> 2) * 128 + ((r8 + 1) & 3) * 16) * 1024 + col0;
        nxt[0] = *(const f32x4*)xp; nxt[1] = *(const f32x4*)(xp + 4); nxt[2] = *(const f32x4*)(xp + 128); nxt[3] = *(const f32x4*)(xp + 132);
      }
      float ss = 0.f;
#pragma unroll
      for (int bj = 0; bj < 2; ++bj) {
        float* xp = xo + row * 1024 + col0 + bj * 128;
        f32x4 v0 = cur[bj * 2] + acc[ai][bj][m][0], v1 = cur[bj * 2 + 1] + acc[ai][bj][m][1];
        *(f32x4*)xp = v0;
        *(f32x4*)(xp + 4) = v1;
        if (feed) *(h16x8*)(copy + row * 1024 + col0 + bj * 128) = pack8(v0, v1);
#pragma unroll
        for (int j = 0; j < 4; ++j) ss += v0[j] * v0[j] + v1[j] * v1[j];
      }
      ss += __shfl_xor(ss, 16, 64);
      ss += __shfl_xor(ss, 32, 64);
      if (fq == 0 && feed) atomicAdd(rss + row, ss);
#pragma unroll
      for (int k = 0; k < 4; ++k) cur[k] = nxt[k];
    }
    return true;
  }
};

struct EpiFF1 {
  h16* hid; const float* rss;
  struct Pre { float v[8]; };
  __device__ __forceinline__ Pre prefetch(const Unit& u, int wr, int fr) const {
    Pre q;
    const int row0 = u.pm * 256 + wr * 64 + fr;
#pragma unroll
    for (int r8 = 0; r8 < 8; ++r8) q.v[r8] = rss[row0 + (r8 >> 2) * 128 + (r8 & 3) * 16];
    return q;
  }
  __device__ __forceinline__ bool operator()(f32x4 (&acc)[2][2][4][2], const Unit& u, const Pre& pre, int wr, int wc, int fr, int fq) const {
    const int row0 = u.pm * 256 + wr * 64 + fr, col0 = u.pn * 256 + wc * 32 + 8 * fq;
    FOR_ROWS {
      const size_t row = row0 + ai * 128 + m * 16;
      const float rs = rsqrtf(pre.v[ai * 4 + m] * (1.f / 1024.f) + EPS);
#pragma unroll
      for (int bj = 0; bj < 2; ++bj) {
        f32x4 v0 = acc[ai][bj][m][0] * rs, v1 = acc[ai][bj][m][1] * rs;
#pragma unroll
        for (int j = 0; j < 4; ++j) {
          float a = fmaxf(v0[j], 0.f), b = fmaxf(v1[j], 0.f);
          v0[j] = a * a; v1[j] = b * b;
        }
        *(h16x8*)(hid + row * LDH + col0 + bj * 128) = pack8(v0, v1);
      }
    }
    return true;
  }
};

__device__ __forceinline__ void zero_f32(float* p, int n) {
  CTX;
  for (int i = BIDX * 512 + TIDX; i < n; i += gridDim.x * 512) p[i] = 0.f;
}

__device__ void phase_inproj(const Params& p, int l, char* shm) {
  CTX;
  zero_f32(p.rssH, TG);
  SchedTiles S{(const char*)p.bufA, (const char*)(p.wt + (size_t)l * WL + O_WIN), (size_t)256 * 1024 * 2, (size_t)256 * 1024 * 2, 30, 64 * 30, (int)gridDim.x, (int)BIDX};
  EpiInproj E{p.proj, p.dtbuf, p.rssX};
  gemm_phase((LAS unsigned char*)shm, 1024, 1024, 16, S, E);
}
__device__ void phase_merge(const Params& p, int l, char* shm) {
  CTX;
  SchedMerge S{(const char*)p.proj, (const char*)(p.wt + (size_t)l * WL), (int)gridDim.x, (int)BIDX};
  EpiMerge E{p.proj, p.bufA, p.ssq};
  gemm_phase((LAS unsigned char*)shm, LDP, 512, 8, S, E);
}
__device__ void phase_wout(const Params& p, int g, int l, char* shm) {
  CTX;
  SchedTiles S{(const char*)p.bufA, (const char*)(p.wt + (size_t)l * WL + O_WOUT), (size_t)256 * 1024 * 2, (size_t)256 * 1024 * 2, 4, 256, (int)gridDim.x, (int)BIDX};
  EpiResid E{p.out + (size_t)g * TG * 1024, p.bufB, p.rssH, 1};
  gemm_phase((LAS unsigned char*)shm, 1024, 1024, 16, S, E);
}
__device__ void phase_ff1(const Params& p, int l, char* shm) {
  CTX;
  zero_f32(p.rssX, TG);
  SchedTiles S{(const char*)p.bufB, (const char*)(p.wt + (size_t)l * WL + O_FF1), (size_t)256 * 1024 * 2, (size_t)256 * 1024 * 2, 16, 64 * 16, (int)gridDim.x, (int)BIDX};
  EpiFF1 E{p.proj, p.rssH};
  gemm_phase((LAS unsigned char*)shm, 1024, 1024, 16, S, E);
}
__device__ void phase_ff2(const Params& p, int g, int l, char* shm) {
  CTX;
  SchedTiles S{(const char*)p.proj, (const char*)(p.wt + (size_t)l * WL + O_FF2), (size_t)256 * LDH * 2, (size_t)256 * LDH * 2, 4, 256, (int)gridDim.x, (int)BIDX};
  EpiResid E{p.out + (size_t)g * TG * 1024, p.bufA, p.rssX, l < NLAYER - 1};
  gemm_phase((LAS unsigned char*)shm, LDH, LDH, 64, S, E);
}

__device__ __forceinline__ int t5_bucket(int rel) {
  int ret = rel > 0 ? 16 : 0;
  int n = rel < 0 ? -rel : rel;
  if (n < 8) return ret + n;
  int large = 8;
#pragma unroll
  for (int k = 1; k <= 7; ++k) large += (n * n >= (64 << k)) ? 1 : 0;
  return ret + min(large, 15);
}

__device__ void phase_attn(const Params& p, int g, int l, char* shm, int dry) {
  CTX;
  const int S = (g < 2) ? 2048 : 8192;
  constexpr int KS = 72, KP = 408;
  h16* Ks = (h16*)shm;
  h16* VT = Ks + 384 * KS;
  float* bias_s = (float*)(VT + 64 * KP);
  const int wid = TIDX >> 6, lane = TIDX & 63, fr = lane & 15, fq = lane >> 4;
  const float* kg = p.k_norm_g + l * 64;
  const float* qg = p.q_norm_g + l * 64;
  const int nitems = (TG / 128) * 2;
  for (int item = BIDX; item < nitems; item += gridDim.x) {
    const int hk = item & 1, blk = item >> 1;
    const int t0 = blk * 128, seq = t0 / S, q0 = t0 % S;
#pragma unroll
    for (int i = TIDX; i < 4 * 257; i += 512) {
      int gq = i / 257, rel = i % 257 - 128;
      bias_s[i] = p.rel_bias[t5_bucket(rel) * 8 + hk * 4 + gq];
    }
    const int gq = wid >> 1, hq = hk * 4 + gq;
    h16x8 qa_n, qb_n;
    {
      const h16* qr0 = p.proj + (size_t)(seq * S + q0 + (wid & 1) * 64 + fr) * LDP + CQ + hq * 64;
      qa_n = *(const h16x8*)(qr0 + fq * 8); qb_n = *(const h16x8*)(qr0 + 32 + fq * 8);
    }
    float qgA[8], qgB[8];
#pragma unroll
    for (int j = 0; j < 8; ++j) { qgA[j] = qg[fq * 8 + j]; qgB[j] = qg[32 + fq * 8 + j]; }
    for (int i = TIDX; i < 64 * 24; i += 512) VT[(i / 24) * KP + 384 + (i % 24)] = (h16)0.f;
    {
      h16x8 kvr[6], vvr[6];
#pragma unroll
      for (int k = 0; k < 6; ++k) {
        int task = TIDX + k * 512, r = task >> 3, c = (task & 7) * 8;
        int kp = q0 - 128 + r;
        const h16x8 zero = {0, 0, 0, 0, 0, 0, 0, 0};
        const bool valid = (kp >= 0) && (kp < S);
        const h16* rp = p.proj + (size_t)(seq * S + min(max(kp, 0), S - 1)) * LDP;
        kvr[k] = *(const h16x8*)(rp + CK + hk * 64 + c);
        vvr[k] = *(const h16x8*)(rp + CV + hk * 64 + c);
        kvr[k] = valid ? kvr[k] : zero;
        vvr[k] = valid ? vvr[k] : zero;
      }
#pragma unroll
      for (int k = 0; k < 6; ++k) {
        int task = TIDX + k * 512, r = task >> 3, c = (task & 7) * 8;
        float kf[8], ss = 0.f;
#pragma unroll
        for (int j = 0; j < 8; ++j) { kf[j] = (float)kvr[k][j]; ss += kf[j] * kf[j]; }
        ss += __shfl_xor(ss, 1, 64);
        ss += __shfl_xor(ss, 2, 64);
        ss += __shfl_xor(ss, 4, 64);
        float rs = rsqrtf(ss * (1.f / 64.f) + EPS);
        h16x8 kn;
#pragma unroll
        for (int j = 0; j < 8; ++j) { kn[j] = (h16)(kf[j] * rs * kg[c + j]); VT[(c + j) * KP + r] = vvr[k][j]; }
        *(h16x8*)(Ks + r * KS + c) = kn;
      }
    }
    __syncthreads();
    const bool edge = (q0 == 0) || (q0 == S - 128);
    const float sinkv = p.attn_sink[l * 8 + hq];
#pragma unroll 1
    for (int qi = 0; qi < 4; ++qi) {
      const int qt = (wid & 1) * 4 + qi, i = qt * 16 + fr;
      h16* qrow = p.proj + (size_t)(seq * S + q0 + i) * LDP + CQ + hq * 64;
      h16x8 qa = qa_n, qb = qb_n;
      if (qi < 3) {
        const h16* qrn = qrow + (size_t)16 * LDP;
        qa_n = *(const h16x8*)(qrn + fq * 8); qb_n = *(const h16x8*)(qrn + 32 + fq * 8);
      }
      {
        float ss = 0.f;
#pragma unroll
        for (int j = 0; j < 8; ++j) ss += (float)qa[j] * (float)qa[j] + (float)qb[j] * (float)qb[j];
        ss += __shfl_xor(ss, 16, 64);
        ss += __shfl_xor(ss, 32, 64);
        const float rs = rsqrtf(ss * (1.f / 64.f) + EPS) * 0.125f;
#pragma unroll
        for (int j = 0; j < 8; ++j) {
          qa[j] = (h16)((float)qa[j] * rs * qgA[j]);
          qb[j] = (h16)((float)qb[j] * rs * qgB[j]);
        }
      }
      f32x4 sc[18];
#pragma unroll
      for (int kt = 0; kt < 17; ++kt) {
        const h16* kr = Ks + ((qt + kt) * 16 + fr) * KS + fq * 8;
        f32x4 acc = {0.f, 0.f, 0.f, 0.f};
        acc = __builtin_amdgcn_mfma_f32_16x16x32_f16(*(const h16x8*)kr, qa, acc, 0, 0, 0);
        acc = __builtin_amdgcn_mfma_f32_16x16x32_f16(*(const h16x8*)(kr + 32), qb, acc, 0, 0, 0);
        sc[kt] = acc;
      }
      sc[17] = f32x4{0.f, 0.f, 0.f, 0.f};
      float mx = sinkv;
      const int d0 = 4 * fq - fr;
      const float* bl = bias_s + gq * 257 + d0;
      if (!edge) {
#pragma unroll
        for (int kt = 0; kt < 17; ++kt) {
#pragma unroll
          for (int j = 0; j < 4; ++j) {
            const int rel = kt * 16 + d0 + j;
            float s;
            if (kt == 0) s = (rel >= 0) ? sc[kt][j] + bl[max(j, -d0)] : -1e30f;
            else if (kt == 16) s = (rel <= 256) ? sc[kt][j] + bl[min(256 + j, 256 - d0)] : -1e30f;
            else s = sc[kt][j] + bl[kt * 16 + j];
            sc[kt][j] = s;
            mx = fmaxf(mx, s);
          }
        }
      } else {
#pragma unroll
        for (int kt = 0; kt < 17; ++kt) {
#pragma unroll
          for (int j = 0; j < 4; ++j) {
            const int r = (qt + kt) * 16 + 4 * fq + j, rel = r - i, kp = q0 - 128 + r;
            const bool valid = (rel >= 0) && (rel <= 256) && (kp >= 0) && (kp < S);
            const float s = valid ? sc[kt][j] + bias_s[gq * 257 + min(max(rel, 0), 256)] : -1e30f;
            sc[kt][j] = s;
            mx = fmaxf(mx, s);
          }
        }
      }
      mx = fmaxf(mx, __shfl_xor(mx, 16, 64));
      mx = fmaxf(mx, __shfl_xor(mx, 32, 64));
      float sum = 0.f;
#pragma unroll
      for (int kt = 0; kt < 17; ++kt) {
#pragma unroll
        for (int j = 0; j < 4; ++j) { float pe = __expf(sc[kt][j] - mx); sc[kt][j] = pe; sum += pe; }
      }
      sum += __shfl_xor(sum, 16, 64);
      sum += __shfl_xor(sum, 32, 64);
      sum += __expf(sinkv - mx);
      const float inv = 1.f / sum;
      h16x8 pb[9];
#pragma unroll
      for (int u = 0; u < 9; ++u) {
#pragma unroll
        for (int j = 0; j < 4; ++j) { pb[u][j] = (h16)sc[2 * u][j]; pb[u][4 + j] = (h16)sc[2 * u + 1][j]; }
      }
#pragma unroll
      for (int dt = 0; dt < 4; ++dt) {
        f32x4 acc = {0.f, 0.f, 0.f, 0.f};
        const h16* vr = VT + (dt * 16 + fr) * KP + qt * 16 + 4 * fq;
#pragma unroll
        for (int u = 0; u < 9; ++u) {
          h16x4 va = *(const h16x4*)(vr + u * 32), vb = *(const h16x4*)(vr + u * 32 + 16);
          h16x8 a = {va[0], va[1], va[2], va[3], vb[0], vb[1], vb[2], vb[3]};
          acc = __builtin_amdgcn_mfma_f32_16x16x32_f16(a, pb[u], acc, 0, 0, 0);
        }
        h16x4 ov = {(h16)(acc[0] * inv), (h16)(acc[1] * inv), (h16)(acc[2] * inv), (h16)(acc[3] * inv)};
        if (!dry) *(h16x4*)(qrow + dt * 16 + 4 * fq) = ov;
      }
    }
    __syncthreads();
  }
}

__device__ void phase_gmlp(const Params& p, int l, char* shm, int dry) {
  CTX;
  constexpr int GP = 136;
  h16* vnT = (h16*)shm;
  h16* Ws = vnT + 128 * GP;
  float* mean_s = (float*)(Ws + 128 * GP);
  float* rstd_s = mean_s + 128;
  const int wid = TIDX >> 6, lane = TIDX & 63, fr = lane & 15, fq = lane >> 4;
  const float* lng = p.gmlp_ln_g + l * 512;
  const float* lnb = p.gmlp_ln_b + l * 512;
  const int nitems = (TG / 128) * 2;
  for (int item = BIDX; item < nitems; item += gridDim.x) {
    const int half = item & 1, t0 = (item >> 1) * 128;
    const int row = TIDX >> 2, part = TIDX & 3;
    const h16* rp = p.proj + (size_t)(t0 + row) * LDP + CGV;
    {
      float sum = 0.f, sq = 0.f;
#pragma unroll
      for (int c = 0; c < 128; c += 8) {
        h16x8 v = *(const h16x8*)(rp + part * 128 + c);
#pragma unroll
        for (int j = 0; j < 8; ++j) { float ge = gelu_t((float)v[j]); sum += ge; sq += ge * ge; }
      }
      sum += __shfl_xor(sum, 1, 64); sum += __shfl_xor(sum, 2, 64);
      sq += __shfl_xor(sq, 1, 64); sq += __shfl_xor(sq, 2, 64);
      float mean = sum * (1.f / 512.f);
      float var = fmaxf(sq * (1.f / 512.f) - mean * mean, 0.f);
      if (part == 0) { mean_s[row] = mean; rstd_s[row] = rsqrtf(var + EPS); }
    }
#pragma unroll 1
    for (int gi = 0; gi < 2; ++gi) {
      const int grp = half * 2 + gi;
      __syncthreads();
      {
        const float mean = mean_s[row], rstd = rstd_s[row];
#pragma unroll
        for (int c = 0; c < 32; c += 8) {
          int cl = part * 32 + c;
          h16x8 v = *(const h16x8*)(rp + grp * 128 + cl);
#pragma unroll
          for (int j = 0; j < 8; ++j) {
            float ge = gelu_t((float)v[j]);
            vnT[(cl + j) * GP + row] = (h16)((ge - mean) * rstd * lng[grp * 128 + cl + j] + lnb[grp * 128 + cl + j]);
          }
        }
        const h16* w = p.wt + (size_t)l * WL + O_WSP + grp * 16384;
#pragma unroll
        for (int k = 0; k < 4; ++k) {
          int e = (TIDX + k * 512) * 8, tt = e >> 7, s0 = e & 127;
          *(h16x8*)(Ws + tt * GP + s0) = *(const h16x8*)(w + e);
        }
      }
      __syncthreads();
      const int t = wid * 16 + fr;
      h16x8 bfrag[4];
#pragma unroll
      for (int ks = 0; ks < 4; ++ks) bfrag[ks] = *(const h16x8*)(Ws + t * GP + ks * 32 + fq * 8);
      const float bsv = p.b_spatial[(size_t)l * 512 + grp * 128 + t];
      h16* ubase = p.proj + (size_t)(t0 + t) * LDP + CGU + grp * 128 + 4 * fq;
      h16x4 uvs[8];
#pragma unroll
      for (int et = 0; et < 8; ++et) uvs[et] = *(const h16x4*)(ubase + et * 16);
#pragma unroll
      for (int et = 0; et < 8; ++et) {
        f32x4 acc = {0.f, 0.f, 0.f, 0.f};
#pragma unroll
        for (int ks = 0; ks < 4; ++ks)
          acc = __builtin_amdgcn_mfma_f32_16x16x32_f16(*(const h16x8*)(vnT + (et * 16 + fr) * GP + ks * 32 + fq * 8), bfrag[ks], acc, 0, 0, 0);
        h16* up = ubase + et * 16;
        h16x4 uv = uvs[et], ov;
#pragma unroll
        for (int j = 0; j < 4; ++j) ov[j] = (h16)(gelu_t((float)uv[j]) * (acc[j] + bsv));
        if (!dry) *(h16x4*)up = ov;
      }
    }
    __syncthreads();
  }
}

constexpr int SP = 136;
struct Raw3 { h16x8 p, c, n; };
__device__ __forceinline__ Raw3 conv_load(const h16* rp, bool hp, bool hn) {
  const h16x8 zero = {0, 0, 0, 0, 0, 0, 0, 0};
  Raw3 r;
  r.c = *(const h16x8*)rp;
  r.p = *(const h16x8*)(hp ? rp - LDP : rp);
  r.n = *(const h16x8*)(hn ? rp + LDP : rp);
  r.p = hp ? r.p : zero;
  r.n = hn ? r.n : zero;
  return r;
}
__device__ __forceinline__ void conv_apply(const Raw3& r, const float4* __restrict__ cwS, float (&o)[8]) {
#pragma unroll
  for (int j = 0; j < 8; ++j) {
    const float4 w = cwS[j];
    float v = w.w + (float)r.p[j] * w.x + (float)r.c[j] * w.y + (float)r.n[j] * w.z;
    o[j] = silu_f(v);
  }
}
__device__ __forceinline__ void ssd_dt_cum(const Params& p, int l, int t0, int grp, float* dts, float* cums, int TIDX) {
#pragma unroll
  for (int i = TIDX; i < 2048; i += 512) {
    int tok = i >> 4, j = i & 15, col = (j >> 3) * 16 + grp * 8 + (j & 7);
    float v = p.dtbuf[(size_t)(t0 + tok) * 32 + col] + p.dt_bias[l * 32 + col];
    dts[j * 128 + tok] = (v > 20.f) ? v : log1pf(expf(v));
  }
  __syncthreads();
  const int wid = TIDX >> 6, lane = TIDX & 63;
#pragma unroll
  for (int k = 0; k < 2; ++k) {
    const int combo = wid * 2 + k, dir = combo >> 3;
    const float a = -expf(p.a_log[l * 32 + dir * 16 + grp * 8 + (combo & 7)]);
    const int e0 = lane * 2;
    const int ta = dir ? 127 - e0 : e0, tb = dir ? 126 - e0 : e0 + 1;
    float v0 = dts[combo * 128 + ta] * a, v1 = dts[combo * 128 + tb] * a;
    float s = v0 + v1;
#pragma unroll
    for (int o = 1; o < 64; o <<= 1) {
      float n = __shfl_up(s, o, 64);
      if (lane >= o) s += n;
    }
    cums[combo * 128 + tb] = s;
    cums[combo * 128 + ta] = s - v1;
  }
  __syncthreads();
}

__device__ void phase_ssd_state(const Params& p, int g, int l, char* shm) {
  CTX;
  const int S = (g < 2) ? 2048 : 8192;
  h16* BT = (h16*)shm;
  h16* XT = BT + 128 * SP;
  float* dts = (float*)(XT + 64 * SP);
  float* cums = dts + 2048;
  h16* wv = (h16*)(cums + 2048);
  float4* cwS = (float4*)(wv + 2048);
  const int wid = TIDX >> 6, lane = TIDX & 63, fr = lane & 15, fq = lane >> 4;
  const float* cw = p.conv_w + (size_t)l * 4608;
  const float* cb = p.conv_b + (size_t)l * 1536;
  for (int item = BIDX; item < 256; item += gridDim.x) {
    const int grp = item & 1, ch = item >> 1, t0 = ch * 128, tl0 = t0 & (S - 1);
#pragma unroll
    for (int i = TIDX; i < 640; i += 512) {
      int c = (i < 128) ? 1024 + grp * 128 + i : grp * 512 + (i - 128);
      cwS[i] = float4{cw[c], cw[1536 + c], cw[3072 + c], cb[c]};
    }
    const int cs = TIDX & 127, cc8 = (TIDX >> 7) * 8;
    const bool hp = tl0 + cs > 0, hn = tl0 + cs < S - 1;
    const h16* xrow = p.proj + (size_t)(t0 + cs) * LDP + CX;
    Raw3 br[4];
#pragma unroll
    for (int k = 0; k < 4; ++k) br[k] = conv_load(xrow + 1024 + grp * 128 + cc8 + k * 32, hp, hn);
    Raw3 xr[2];
#pragma unroll
    for (int k = 0; k < 2; ++k) xr[k] = conv_load(xrow + grp * 512 + cc8 + k * 32, hp, hn);
    ssd_dt_cum(p, l, t0, grp, dts, cums, TIDX);
#pragma unroll
    for (int i = TIDX; i < 2048; i += 512) {
      int combo = i >> 7;
      float cend = cums[combo * 128 + ((combo >> 3) ? 0 : 127)];
      wv[i] = (h16)(__expf(cend - cums[i]) * dts[i]);
    }
    if (TIDX < 16) p.dec[(ch * 2 + grp) * 16 + TIDX] = __expf(cums[TIDX * 128 + ((TIDX >> 3) ? 0 : 127)]);
#pragma unroll
    for (int k = 0; k < 4; ++k) {
      float o[8];
      conv_apply(br[k], cwS + cc8 + k * 32, o);
#pragma unroll
      for (int j = 0; j < 8; ++j) BT[(cc8 + k * 32 + j) * SP + cs] = (h16)o[j];
    }
    __syncthreads();
    h16x8 af[4];
#pragma unroll
    for (int ks = 0; ks < 4; ++ks) af[ks] = *(const h16x8*)(BT + (wid * 16 + fr) * SP + ks * 32 + fq * 8);
#pragma unroll 1
    for (int hh = 0; hh < 8; ++hh) {
      __syncthreads();
#pragma unroll
      for (int k = 0; k < 2; ++k) {
        float o[8];
        conv_apply(xr[k], cwS + 128 + hh * 64 + cc8 + k * 32, o);
#pragma unroll
        for (int j = 0; j < 8; ++j) XT[(cc8 + k * 32 + j) * SP + cs] = (h16)o[j];
      }
      if (hh < 7) {
#pragma unroll
        for (int k = 0; k < 2; ++k) xr[k] = conv_load(xrow + grp * 512 + (hh + 1) * 64 + cc8 + k * 32, hp, hn);
      }
      __syncthreads();
#pragma unroll
      for (int dir = 0; dir < 2; ++dir) {
        const int combo = dir * 8 + hh;
        h16* stp = p.st + ((((size_t)ch * 2 + grp) * 2 + dir) * 8 + hh) * 8192;
#pragma unroll
        for (int pt = 0; pt < 4; ++pt) {
          f32x4 acc = {0.f, 0.f, 0.f, 0.f};
#pragma unroll
          for (int ks = 0; ks < 4; ++ks) {
            h16x8 xb = *(const h16x8*)(XT + (pt * 16 + fr) * SP + ks * 32 + fq * 8) * *(const h16x8*)(wv + combo * 128 + ks * 32 + fq * 8);
            acc = __builtin_amdgcn_mfma_f32_16x16x32_f16(af[ks], xb, acc, 0, 0, 0);
          }
          h16x4 o4 = {(h16)acc[0], (h16)acc[1], (h16)acc[2], (h16)acc[3]};
          *(h16x4*)(stp + (pt * 16 + fr) * 128 + wid * 16 + 4 * fq) = o4;
        }
      }
    }
    __syncthreads();
  }
}

template <int W>
__device__ __forceinline__ void ssd_scan_body(const Params& p, int g, int dry, int TIDX, int BIDX) {
  typedef _Float16 hv __attribute__((ext_vector_type(W)));
  const int S = (g < 2) ? 2048 : 8192, nc = S / 128, nseq = TG / S;
  constexpr int VPC = 8192 / W;
  const int total = nseq * 32 * VPC;
  for (int idx = BIDX * 512 + TIDX; idx < total; idx += gridDim.x * 512) {
    const int v = idx % VPC, combo = (idx / VPC) & 31, seq = idx / (VPC * 32), dir = (combo >> 3) & 1;
    float carry[W];
#pragma unroll
    for (int j = 0; j < W; ++j) carry[j] = 0.f;
    for (int i = 0; i < nc; i += 8) {
      hv L[8]; float d[8]; h16* ptr[8];
#pragma unroll
      for (int u = 0; u < 8; ++u) {
        int c = dir ? nc - 1 - (i + u) : (i + u);
        int chg = seq * nc + c;
        ptr[u] = p.st + ((size_t)chg * 32 + combo) * 8192 + v * W;
        L[u] = *(const hv*)ptr[u];
        d[u] = p.dec[chg * 32 + combo];
      }
#pragma unroll
      for (int u = 0; u < 8; ++u) {
        hv o;
#pragma unroll
        for (int j = 0; j < W; ++j) { o[j] = (h16)carry[j]; carry[j] = carry[j] * d[u] + (float)L[u][j]; }
        if (!dry) *(hv*)ptr[u] = o;
      }
    }
  }
}
__device__ void phase_ssd_scan(const Params& p, int g, int dry) {
  CTX;
  if (g < 2) ssd_scan_body<8>(p, g, dry, TIDX, BIDX);
  else ssd_scan_body<4>(p, g, dry, TIDX, BIDX);
}

__device__ void phase_ssd_out(const Params& p, int g, int l, char* shm, int dry) {
  CTX;
  const int S = (g < 2) ? 2048 : 8192;
  h16* Cs = (h16*)shm;
  h16* Bs = Cs + 128 * SP;
  h16* Sf = Bs;
  h16* Sb = Bs + 64 * SP;
  h16* XT = Bs + 128 * SP;
  h16* Ms = XT + 64 * SP;
  float* dts = (float*)(Ms + 128 * SP);
  float* cums = dts + 2048;
  float4* cwS = (float4*)(cums + 2048);
  const int wid = TIDX >> 6, lane = TIDX & 63, fr = lane & 15, fq = lane >> 4;
  const float* cw = p.conv_w + (size_t)l * 4608;
  const float* cb = p.conv_b + (size_t)l * 1536;
  for (int item = BIDX; item < 256; item += gridDim.x) {
    const int grp = item & 1, ch = item >> 1, t0 = ch * 128, tl0 = t0 & (S - 1);
#pragma unroll
    for (int i = TIDX; i < 768; i += 512) {
      int c = (i < 128) ? 1024 + grp * 128 + i : (i < 256) ? 1280 + grp * 128 + (i - 128) : grp * 512 + (i - 256);
      cwS[i] = float4{cw[c], cw[1536 + c], cw[3072 + c], cb[c]};
    }
    const int cs = TIDX & 127, cc8 = (TIDX >> 7) * 8;
    const bool hp = tl0 + cs > 0, hn = tl0 + cs < S - 1;
    const h16* xrow = p.proj + (size_t)(t0 + cs) * LDP + CX;
    Raw3 br[4];
#pragma unroll
    for (int k = 0; k < 4; ++k) br[k] = conv_load(xrow + 1024 + grp * 128 + cc8 + k * 32, hp, hn);
    ssd_dt_cum(p, l, t0, grp, dts, cums, TIDX);
#pragma unroll
    for (int k = 0; k < 4; ++k) {
      float o[8];
      conv_apply(br[k], cwS + cc8 + k * 32, o);
      h16x8 ov;
#pragma unroll
      for (int j = 0; j < 8; ++j) ov[j] = (h16)o[j];
      *(h16x8*)(Bs + cs * SP + cc8 + k * 32) = ov;
    }
#pragma unroll
    for (int k = 0; k < 4; ++k) br[k] = conv_load(xrow + 1280 + grp * 128 + cc8 + k * 32, hp, hn);
    Raw3 xr[2];
#pragma unroll
    for (int k = 0; k < 2; ++k) xr[k] = conv_load(xrow + grp * 512 + cc8 + k * 32, hp, hn);
    const int sc8 = (TIDX & 15) * 8;
    const h16* stb = p.st + (((size_t)ch * 2 + grp) * 2) * 8 * 8192;
#pragma unroll
    for (int k = 0; k < 4; ++k) {
      float o[8];
      conv_apply(br[k], cwS + 128 + cc8 + k * 32, o);
      h16x8 ov;
#pragma unroll
      for (int j = 0; j < 8; ++j) ov[j] = (h16)o[j];
      *(h16x8*)(Cs + cs * SP + cc8 + k * 32) = ov;
    }
    __syncthreads();
    const int lcol = wid * 16 + fr;
    f32x4 cbT[8];
#pragma unroll
    for (int st = 0; st < 8; ++st) {
      f32x4 acc = {0.f, 0.f, 0.f, 0.f};
#pragma unroll
      for (int ks = 0; ks < 4; ++ks) {
        h16x8 a = *(const h16x8*)(Bs + (st * 16 + fr) * SP + ks * 32 + fq * 8);
        acc = __builtin_amdgcn_mfma_f32_16x16x32_f16(a, *(const h16x8*)(Cs + lcol * SP + ks * 32 + fq * 8), acc, 0, 0, 0);
      }
      cbT[st] = acc;
    }
    float ssq_acc = 0.f;
    h16* zrow = p.proj + (size_t)(t0 + lcol) * LDP + CZ + grp * 512 + 4 * fq;
#pragma unroll 1
    for (int hh = 0; hh < 8; ++hh) {
      __syncthreads();
      h16x8 sfr[4];
#pragma unroll
      for (int k = 0; k < 4; ++k) {
        int task = TIDX + k * 512, which = task >> 10, r = (task >> 4) & 63;
        sfr[k] = *(const h16x8*)(stb + ((size_t)which * 8 + hh) * 8192 + r * 128 + sc8);
      }
#pragma unroll
      for (int k = 0; k < 2; ++k) {
        float o[8];
        conv_apply(xr[k], cwS + 256 + hh * 64 + cc8 + k * 32, o);
#pragma unroll
        for (int j = 0; j < 8; ++j) XT[(cc8 + k * 32 + j) * SP + cs] = (h16)o[j];
      }
      if (hh < 7) {
#pragma unroll
        for (int k = 0; k < 2; ++k) xr[k] = conv_load(xrow + grp * 512 + (hh + 1) * 64 + cc8 + k * 32, hp, hn);
      }
      h16x4 zv[4];
#pragma unroll
      for (int pt = 0; pt < 4; ++pt) zv[pt] = *(const h16x4*)(zrow + hh * 64 + pt * 16);
      const float cfl = cums[hh * 128 + lcol], cbl = cums[(8 + hh) * 128 + lcol];
#pragma unroll
      for (int st = 0; st < 8; ++st) {
        const int s0 = st * 16 + 4 * fq;
        f32x4 cfs = *(const f32x4*)(cums + hh * 128 + s0), cbs = *(const f32x4*)(cums + (8 + hh) * 128 + s0);
        f32x4 dfs = *(const f32x4*)(dts + hh * 128 + s0), dbs = *(const f32x4*)(dts + (8 + hh) * 128 + s0);
        h16x4 mv;
#pragma unroll
        for (int j = 0; j < 4; ++j) {
          const int s = s0 + j;
          float e = (s <= lcol) ? cfl - cfs[j] : cbl - cbs[j];
          float d = (s <= lcol) ? dfs[j] : dbs[j];
          float v = __expf(e) * d;
          if (s == lcol) v = dfs[j] + dbs[j];
          mv[j] = (h16)(cbT[st][j] * v);
        }
        *(h16x4*)(Ms + lcol * SP + s0) = mv;
      }
#pragma unroll
      for (int k = 0; k < 4; ++k) {
        int task = TIDX + k * 512, which = task >> 10, r = (task >> 4) & 63;
        *(h16x8*)((which ? Sb : Sf) + r * SP + sc8) = sfr[k];
      }
      __syncthreads();
      h16x8 mfrag[4];
#pragma unroll
      for (int ks = 0; ks < 4; ++ks) mfrag[ks] = *(const h16x8*)(Ms + lcol * SP + ks * 32 + fq * 8);
      const float ecf = __expf(cfl), ecb = __expf(cbl), Dk = p.d_skip[l * 16 + grp * 8 + hh];
#pragma unroll
      for (int pt = 0; pt < 4; ++pt) {
        f32x4 aY = {0.f, 0.f, 0.f, 0.f}, aF = aY, aB = aY;
#pragma unroll
        for (int ks = 0; ks < 4; ++ks) {
          const int o = (pt * 16 + fr) * SP + ks * 32 + fq * 8;
          aY = __builtin_amdgcn_mfma_f32_16x16x32_f16(*(const h16x8*)(XT + o), mfrag[ks], aY, 0, 0, 0);
          const h16x8 cf = *(const h16x8*)(Cs + lcol * SP + ks * 32 + fq * 8);
          aF = __builtin_amdgcn_mfma_f32_16x16x32_f16(*(const h16x8*)(Sf + o), cf, aF, 0, 0, 0);
          aB = __builtin_amdgcn_mfma_f32_16x16x32_f16(*(const h16x8*)(Sb + o), cf, aB, 0, 0, 0);
        }
        const int p0 = pt * 16 + 4 * fq;
        h16x4 ov;
#pragma unroll
        for (int j = 0; j < 4; ++j) {
          float x = (float)XT[(p0 + j) * SP + lcol];
          float y = aY[j] + ecf * aF[j] + ecb * aB[j] + Dk * x;
          float gt = y * silu_f((float)zv[pt][j]);
          ssq_acc += gt * gt;
          ov[j] = (h16)gt;
        }
        if (!dry) *(h16x4*)(zrow + hh * 64 + pt * 16) = ov;
      }
    }
    ssq_acc += __shfl_xor(ssq_acc, 16, 64);
    ssq_acc += __shfl_xor(ssq_acc, 32, 64);
    if (fq == 0 && !dry) p.ssq[(size_t)(t0 + lcol) * 2 + grp] = ssq_acc;
    __syncthreads();
  }
}

#define XB_TMO 128
#define XB_XCNT(j) (256 + 64 * (j))
#define XB_XSUB(j) (1280 + 64 * (j))
#define XB_XGEN(j) (2304 + 64 * (j))
#define XB_TOP 3328
#define XB_TOPGEN 3392
#define XCD_BAR_WORDS 3456
#define XB_SPIN_CAP (1u << 20)
__device__ __forceinline__ unsigned xb_ld(unsigned* p) { return __hip_atomic_load(p, __ATOMIC_RELAXED, __HIP_MEMORY_SCOPE_AGENT); }
__device__ __forceinline__ unsigned xb_add(unsigned* p, unsigned v) { return __hip_atomic_fetch_add(p, v, __ATOMIC_RELAXED, __HIP_MEMORY_SCOPE_AGENT); }
__device__ __forceinline__ unsigned xb_xcc_id() { return (unsigned)__builtin_amdgcn_s_getreg((3 << 11) | 20) & 0xFu; }
#define XB_SPIN(cond, bar)                                                                        \
  do {                                                                                            \
    unsigned _sp = 0;                                                                             \
    while (cond) {                                                                                \
      __builtin_amdgcn_s_sleep(1);                                                                \
      if ((++_sp & 255u) == 0u) {                                                                 \
        if (xb_ld(&(bar)[XB_TMO])) break;                                                         \
        if (_sp > XB_SPIN_CAP) { atomicAdd(&(bar)[XB_TMO], 1u); break; }                          \
      }                                                                                           \
    }                                                                                             \
  } while (0)
__device__ __forceinline__ void xcd_barrier_complete(unsigned* bar, unsigned x, unsigned& nloc, unsigned& nx) {
  const unsigned G = gridDim.x;
  unsigned sum, cnt, mine, sp = 0u;
  for (;;) {
    sum = 0u; cnt = 0u; mine = 0u;
#pragma unroll
    for (unsigned j = 0; j < 16; ++j) { const unsigned c = xb_ld(&bar[XB_XCNT(j)]); sum += c; cnt += (c > 0u) ? 1u : 0u; mine = (j == x) ? c : mine; }
    if (sum == G) break;
    __builtin_amdgcn_s_sleep(1);
    if ((++sp & 255u) == 0u) { if (xb_ld(&bar[XB_TMO])) break; if (sp > XB_SPIN_CAP) { atomicAdd(&bar[XB_TMO], 1u); break; } }
  }
  nloc = mine > 0u ? mine : 1u; nx = cnt > 0u ? cnt : 1u;
}
__device__ __forceinline__ void xcd_barrier(unsigned* bar, unsigned x, volatile LAS unsigned* st) {
  asm volatile("s_waitcnt vmcnt(0)" ::: "memory");
  __syncthreads();
  if (threadIdx.x == 0) {
    __builtin_amdgcn_s_waitcnt(0);
    unsigned nloc = st[0], nx = st[1];
    if (nloc == 0u) { xcd_barrier_complete(bar, x, nloc, nx); st[0] = nloc; st[1] = nx; }
    const unsigned old = xb_add(&bar[XB_XSUB(x)], 1u);
    const unsigned gen = old / nloc;
    if (old + 1u == (gen + 1u) * nloc) {
      __builtin_amdgcn_fence(__ATOMIC_RELEASE, "agent");
      asm volatile("s_waitcnt vmcnt(0)" ::: "memory");
      const unsigned og = xb_add(&bar[XB_TOP], 1u);
      const unsigned tg = og / nx;
      if (og + 1u == (tg + 1u) * nx) xb_add(&bar[XB_TOPGEN], 1u);
      else XB_SPIN(xb_ld(&bar[XB_TOPGEN]) == tg, bar);
      __builtin_amdgcn_fence(__ATOMIC_ACQUIRE, "agent");
      xb_add(&bar[XB_XGEN(x)], 1u);
      asm volatile("s_waitcnt vmcnt(0)" ::: "memory");
    } else {
      XB_SPIN(xb_ld(&bar[XB_XGEN(x)]) == gen, bar);
      __builtin_amdgcn_fence(__ATOMIC_ACQUIRE, "agent");
      asm volatile("s_waitcnt vmcnt(0)" ::: "memory");
    }
  }
  __syncthreads();
}

__device__ __forceinline__ unsigned long long rd_tab(const unsigned* tab, int i) {
  unsigned lo = __builtin_amdgcn_readfirstlane(tab[2 * i]), hi = __builtin_amdgcn_readfirstlane(tab[2 * i + 1]);
  return ((unsigned long long)hi << 32) | lo;
}
template <class T> __device__ __forceinline__ T* as_global(unsigned long long v) {
  return (T*)(__attribute__((address_space(1))) T*)v;
}
__device__ __forceinline__ Params load_params(const unsigned* tab) {
  Params q;
#define X(i, T, n) q.n = as_global<std::remove_pointer_t<T>>(rd_tab(tab, i));
  PFIELDS(X)
#undef X
  q.step_lo = 0; q.step_hi = 0;
  return q;
}
#define LP const Params p = load_params(tab)
__device__ void run_step(const unsigned* tab, const int s, char* shm) {
#pragma unroll 1
  for (int k = 0; k < 2; ++k) {
    int g = 0, l = 0, ph = 9, pl = -1;
    if (s == 0) pl = 0;
    else {
      const int t = s - 1, r = t & 31;
      g = t >> 5; l = r >> 3; ph = r & 7;
      if (g == 0 && l == 0 && ph >= 1 && ph <= 3) pl = ph;
    }
    const bool prep_first = (s == 0) || (blockIdx.x & 1);
    const int code = (k == 0) ? ((pl >= 0 && prep_first) ? 8 : ph) : ((s == 0) ? 10 : (pl < 0 ? 9 : (prep_first ? ph : 8)));
    switch (code) {
      case 0: { LP; phase_inproj(p, l, shm); } break;
      case 1:
        if (blockIdx.x & 1) { { LP; phase_gmlp(p, l, shm, 0); } { LP; phase_ssd_state(p, g, l, shm); } }
        else { { LP; phase_ssd_state(p, g, l, shm); } { LP; phase_gmlp(p, l, shm, 0); } }
        break;
      case 2:
        if (blockIdx.x & 1) { { LP; phase_attn(p, g, l, shm, 0); } { LP; phase_ssd_scan(p, g, 0); } }
        else { { LP; phase_ssd_scan(p, g, 0); } { LP; phase_attn(p, g, l, shm, 0); } }
        break;
      case 3: { LP; phase_ssd_out(p, g, l, shm, 0); } break;
      case 4: { LP; phase_merge(p, l, shm); } break;
      case 5: { LP; phase_wout(p, g, l, shm); } break;
      case 6: { LP; phase_ff1(p, l, shm); } break;
      case 7: { { LP; phase_ff2(p, g, l, shm); } if (l == NLAYER - 1 && g < 2) { LP; phase_pre(p, g + 1); } } break;
      case 8: { LP; phase_prep(p, shm, pl, pl + 1); } break;
      case 10: { LP; phase_pre(p, 0); } break;
      default: break;
    }
  }
}

__global__ void __launch_bounds__(512, 2) mega(Params p) {
  extern __shared__ __attribute__((aligned(16))) char shm[];
  unsigned long long* tab = (unsigned long long*)(shm + SHM_TAB);
  volatile LAS unsigned* bst = (volatile LAS unsigned*)(LAS unsigned*)(shm + SHM_TAB - 16);
  if (threadIdx.x == 0) {
#define X(i, T, n) tab[i] = (unsigned long long)p.n;
    PFIELDS(X)
#undef X
    bst[0] = 0u; bst[1] = 0u;
  }
  const int lo = p.step_lo, hi = p.step_hi;
  unsigned* bar = p.bar;
  const unsigned xcc = xb_xcc_id();
  __syncthreads();
  if (threadIdx.x == 0) (void)xb_add(&bar[XB_XCNT(xcc)], 1u);
  for (int s = lo; s < hi; ++s) {
    if (s > lo) {
      if (s == lo + 1) cg::this_grid().sync();
      else xcd_barrier(as_global<unsigned>(rd_tab((const unsigned*)tab, 36)), xcc, bst);
    }
    run_step((const unsigned*)tab, s, shm);
  }
}

extern "C" void kernel_launch(void* const* d_in, const int* in_sizes, int n_in, void* d_out, int out_size, void* d_ws,
                              size_t ws_size, hipStream_t stream) {
  Params p{};
  {
    const float** fp = (const float**)&p;
    for (int i = 0; i < 25; ++i) fp[i] = (const float*)d_in[i];
  }
  p.out = (float*)d_out;
  char* ws = (char*)d_ws;
  size_t off = 0;
  p.wt = (h16*)(ws + off); off += (size_t)NLAYER * WL * 2;
  p.proj = (h16*)(ws + off); off += (size_t)TG * LDP * 2;
  p.bufA = (h16*)(ws + off); off += (size_t)TG * 1024 * 2;
  p.bufB = (h16*)(ws + off); off += (size_t)TG * 1024 * 2;
  p.st = (h16*)(ws + off); off += (size_t)64 << 20;
  p.rssX = (float*)(ws + off); off += (size_t)TG * 4;
  p.rssH = (float*)(ws + off); off += (size_t)TG * 4;
  p.dtbuf = (float*)(ws + off); off += (size_t)TG * 32 * 4;
  p.dec = (float*)(ws + off); off += (size_t)128 * 32 * 4;
  p.ssq = (float*)(ws + off); off += (size_t)TG * 2 * 4;
  p.bar = (unsigned*)(ws + off); off += (size_t)XCD_BAR_WORDS * 4;
  static int grid_blocks = 0;
  if (!grid_blocks) {
    (void)hipFuncSetAttribute((const void*)mega, hipFuncAttributeMaxDynamicSharedMemorySize, SHM_TOTAL);
    int dev = 0, cus = 0, per_cu = 0;
    (void)hipGetDevice(&dev);
    (void)hipDeviceGetAttribute(&cus, hipDeviceAttributeMultiprocessorCount, dev);
    (void)hipOccupancyMaxActiveBlocksPerMultiprocessor(&per_cu, mega, 512, SHM_TOTAL);
    grid_blocks = cus * per_cu;
    if (grid_blocks > 256 || grid_blocks <= 0) grid_blocks = 256;
  }
  (void)hipMemsetAsync(p.bar, 0, (size_t)XCD_BAR_WORDS * 4, stream);
#if MULTI_LAUNCH
  for (int s = 0; s < NSTEPS; ++s) {
    p.step_lo = s;
    p.step_hi = s + 1;
    hipLaunchKernelGGL(mega, dim3(grid_blocks), dim3(512), SHM_TOTAL, stream, p);
  }
#else
  p.step_lo = 0;
  p.step_hi = NSTEPS;
  void* args[] = {&p};
  (void)hipLaunchCooperativeKernel((void*)mega, dim3(grid_blocks), dim3(512), args, SHM_TOTAL, stream);
#endif
}
```

```cpp
#include <hip/hip_runtime.h>
#include <hip/hip_fp16.h>
#include <hip/hip_cooperative_groups.h>
#include <type_traits>
namespace cg = cooperative_groups;

#ifndef MULTI_LAUNCH
#define MULTI_LAUNCH 0
#endif

typedef _Float16 h16;
using h16x8 = __attribute__((ext_vector_type(8))) _Float16;
using h16x4 = __attribute__((ext_vector_type(4))) _Float16;
using h16x2 = __attribute__((ext_vector_type(2))) _Float16;
using f32x4 = __attribute__((ext_vector_type(4))) float;

constexpr int LDP = 7456, TG = 16384, NLAYER = 4, LDH = 4160;
constexpr int CQ = 0, CK = 512, CV = 640, CGU = 768, CGV = 1280, CZ = 1792, CX = 2816, CDT = 4352, CG = 4384;
constexpr float EPS = 1e-6f;
constexpr long O_WIN = 0, O_UPA = 7456L * 1024, O_UPB = O_UPA + 524288, O_UPC = O_UPB + 524288, O_WOUT = O_UPC + 1048576,
               O_FF1 = O_WOUT + 1048576, O_FF2 = O_FF1 + 4194304, O_WSP = O_FF2 + 1024L * LDH, WL = O_WSP + 65536;
constexpr int SHM_GEMM = 131072, SHM_TOTAL = 163840, SHM_TAB = 162816;
constexpr int NSTEPS = 1 + 3 * 32;

#define PFIELDS(X)                                                                                                         \
  X(0, const float*, x_prompt) X(1, const float*, x_sample) X(2, const float*, rel_bias) X(3, const float*, norm_mix_g)    \
  X(4, const float*, w_in) X(5, const float*, q_norm_g) X(6, const float*, k_norm_g) X(7, const float*, attn_sink)         \
  X(8, const float*, gmlp_ln_g) X(9, const float*, gmlp_ln_b) X(10, const float*, w_spatial) X(11, const float*, b_spatial) \
  X(12, const float*, conv_w) X(13, const float*, conv_b) X(14, const float*, dt_bias) X(15, const float*, a_log)          \
  X(16, const float*, d_skip) X(17, const float*, ssd_norm_g) X(18, const float*, w_up_attn) X(19, const float*, w_up_gmlp) \
  X(20, const float*, w_up_ssd) X(21, const float*, w_out) X(22, const float*, norm_ff_g) X(23, const float*, w_ff1)       \
  X(24, const float*, w_ff2) X(25, float*, out) X(26, h16*, wt) X(27, h16*, proj) X(28, h16*, bufA) X(29, h16*, bufB)      \
  X(30, h16*, st) X(31, float*, rssX) X(32, float*, rssH) X(33, float*, dtbuf) X(34, float*, dec) X(35, float*, ssq) X(36, unsigned*, bar)
struct Params {
#define X(i, T, n) T n;
  PFIELDS(X)
#undef X
  int step_lo, step_hi;
};

__device__ __forceinline__ float wave_sum(float v) {
#pragma unroll
  for (int o = 32; o > 0; o >>= 1) v += __shfl_xor(v, o, 64);
  return v;
}
__device__ __forceinline__ float gelu_t(float x) {
  float u2 = 1.5957691216057308f * (x + 0.044715f * x * x * x);
  return x * __builtin_amdgcn_rcpf(1.f + __expf(-u2));
}
__device__ __forceinline__ float silu_f(float x) { return x * __builtin_amdgcn_rcpf(1.f + __expf(-x)); }
__device__ __forceinline__ float clampf(float x, float lo, float hi) { return fminf(fmaxf(x, lo), hi); }

__device__ __forceinline__ int opaque_tid() { int t = threadIdx.x; asm volatile("" : "+v"(t)); return t; }
__device__ __forceinline__ int opaque_bid() { int b = blockIdx.x; asm volatile("" : "+s"(b)); return b; }
#define CTX const int TIDX = opaque_tid(); const int BIDX = opaque_bid(); (void)TIDX; (void)BIDX

__device__ void prep_tile(const float* __restrict__ src, int K, int N, h16* __restrict__ dst, const float* __restrict__ scale,
                          int nt, int kt, char* shm, int ldd = 0) {
  CTX;
  float(*tile)[65] = (float(*)[65])shm;
  const int tid = TIDX;
  const int n0 = nt * 64, k0 = kt * 64;
  {
    int nn = tid & 63, kk0 = tid >> 6;
#pragma unroll
    for (int i = 0; i < 8; ++i) {
      int kk = kk0 + 8 * i;
      float v = 0.f;
      if (n0 + nn < N) {
        v = src[(size_t)(k0 + kk) * N + n0 + nn];
        if (scale) v *= scale[k0 + kk];
      }
      tile[kk][nn] = v;
    }
  }
  __syncthreads();
  {
    int kk = tid & 63, nn0 = tid >> 6;
#pragma unroll
    for (int i = 0; i < 8; ++i) {
      int nn = nn0 + 8 * i;
      if (n0 + nn < N) dst[(size_t)(n0 + nn) * (ldd ? ldd : K) + k0 + kk] = (h16)tile[kk][nn];
    }
  }
  __syncthreads();
}

__device__ void phase_prep(const Params& p, char* shm) {
  CTX;
  constexpr int T_IN = 117 * 16, T_UA = 16 * 8, T_UC = 16 * 16, T_F = 64 * 16, T_SP = 16;
  constexpr int PER = T_IN + 2 * T_UA + 2 * T_UC + 2 * T_F + T_SP;
  for (int item = BIDX; item < PER * NLAYER; item += gridDim.x) {
    int l = item / PER, r = item % PER;
    h16* wl = p.wt + (size_t)l * WL;
    if (r < T_IN) { prep_tile(p.w_in + (size_t)l * 1024 * LDP, 1024, LDP, wl + O_WIN, p.norm_mix_g + l * 1024, r / 16, r % 16, shm); continue; }
    r -= T_IN;
    if (r < T_UA) { prep_tile(p.w_up_attn + (size_t)l * 512 * 1024, 512, 1024, wl + O_UPA, nullptr, r / 8, r % 8, shm); continue; }
    r -= T_UA;
    if (r < T_UA) { prep_tile(p.w_up_gmlp + (size_t)l * 512 * 1024, 512, 1024, wl + O_UPB, nullptr, r / 8, r % 8, shm); continue; }
    r -= T_UA;
    if (r < T_UC) { int hf = r >> 7, rr = r & 127; prep_tile(p.w_up_ssd + (size_t)l * 1024 * 1024 + (size_t)hf * 512 * 1024, 512, 1024, wl + O_UPC + hf * 524288, p.ssd_norm_g + l * 1024 + hf * 512, rr / 8, rr % 8, shm); continue; }
    r -= T_UC;
    if (r < T_UC) { prep_tile(p.w_out + (size_t)l * 1024 * 1024, 1024, 1024, wl + O_WOUT, nullptr, r / 16, r % 16, shm); continue; }
    r -= T_UC;
    if (r < T_F) { prep_tile(p.w_ff1 + (size_t)l * 1024 * 4096, 1024, 4096, wl + O_FF1, p.norm_ff_g + l * 1024, r / 16, r % 16, shm); continue; }
    r -= T_F;
    if (r < T_F) { prep_tile(p.w_ff2 + (size_t)l * 4096 * 1024, 4096, 1024, wl + O_FF2, nullptr, r / 64, r % 64, shm, LDH); continue; }
    r -= T_F;
    {
      const float* s = p.w_spatial + (size_t)l * 65536 + r * 4096;
      h16* d = wl + O_WSP + r * 4096;
      for (int i = TIDX; i < 4096; i += 512) d[i] = (h16)s[i];
    }
  }
}

__device__ void phase_pre(const Params& p, int g) {
  CTX;
  const float* xin = (g < 2) ? p.x_prompt + (size_t)g * TG * 1024 : p.x_sample;
  float* xo = p.out + (size_t)g * TG * 1024;
  const int wid = TIDX >> 6, lane = TIDX & 63;
  for (int row = BIDX * 8 + wid; row < TG; row += gridDim.x * 8) {
    const float4* s4 = (const float4*)(xin + (size_t)row * 1024);
    float4* d4 = (float4*)(xo + (size_t)row * 1024);
    float ss = 0.f;
#pragma unroll
    for (int i = 0; i < 4; ++i) {
      int idx = i * 64 + lane;
      float4 v = s4[idx];
      d4[idx] = v;
      ss += v.x * v.x + v.y * v.y + v.z * v.z + v.w * v.w;
      h16x4 hv = {(h16)v.x, (h16)v.y, (h16)v.z, (h16)v.w};
      *(h16x4*)(p.bufA + (size_t)row * 1024 + idx * 4) = hv;
    }
    ss = wave_sum(ss);
    if (lane == 0) p.rssX[row] = ss;
  }
}

#define LAS __attribute__((address_space(3)))
constexpr int BK = 64, HALF = 128, HTB = HALF * BK * 2;
__device__ __forceinline__ int lds_byte(int r, int c) {
  const int st = (r >> 4) * 2 + (c >> 5), rr = r & 15, cc = c & 31, ob = rr * 64 + cc * 2;
  return st * 1024 + (ob ^ (((ob >> 9) & 1) << 5));
}
__device__ __forceinline__ void stage_rc(int b, int& R, int& C) {
  const int st = b / 1024, sb = b % 1024, swz = sb ^ (((sb >> 9) & 1) << 5);
  R = (st >> 1) * 16 + swz / 64;
  C = (st & 1) * 32 + (swz % 64) / 2;
}
__device__ __forceinline__ int perm32(int rho) { const int n = rho >> 4, i = rho & 15; return 8 * (i >> 2) + 4 * n + (i & 3); }

struct Unit { const char* A; const char* B; int pm, pn, seg; };

__device__ __forceinline__ void tile_map(int t, int total, int nN, int& pm, int& pn) {
  int base = t & ~255, i = t & 255;
  int R = min(256, total - base);
  int id = (R & 7) ? t : base + (i & 7) * (R >> 3) + (i >> 3);
  int band = id / (8 * nN), w = id % (8 * nN);
  pm = band * 8 + (w & 7);
  pn = w >> 3;
}

template <class Sched, class Epi>
__device__ __forceinline__ void gemm_phase(LAS unsigned char* lds, const int lda, const int ldb, const int nt, const Sched& S, const Epi& E) {
  CTX;
  const int tid = TIDX, wid = __builtin_amdgcn_readfirstlane(tid >> 6), lane = tid & 63, wr = wid >> 2, wc = wid & 3, fr = lane & 15, fq = lane >> 4;
  unsigned voffA[2], voffB[2];
#pragma unroll
  for (int i = 0; i < 2; ++i) {
    int R, C;
    stage_rc(tid * 16 + i * 8192, R, C);
    const int Rb = (R & ~31) + perm32(R & 31);
    voffA[i] = (unsigned)(R * lda + C) * 2u;
    voffB[i] = (unsigned)(Rb * ldb + C) * 2u;
  }
  const size_t kstep = (size_t)(BK * 2);
  const size_t hstepA = (size_t)HALF * lda * 2, hstepB = (size_t)HALF * ldb * 2;
  const unsigned ldsw = (unsigned)wid * 1024u;
  const int aoff = lds_byte(wr * 64 + fr, fq * 8), boff = lds_byte(wc * 32 + fr, fq * 8);
#define G_SA(b, h) (((b)*2 + (h)) * HTB)
#define G_SB(b, h) ((4 + (b)*2 + (h)) * HTB)
#define G_STAGE(bufoff, gbase, voff)                                                                                        \
  do {                                                                                                                      \
    _Pragma("unroll") for (int _i = 0; _i < 2; ++_i) __builtin_amdgcn_global_load_lds(                                      \
        (const unsigned*)((const char*)(gbase) + (voff)[_i]), (LAS unsigned*)(lds + (bufoff) + ldsw + _i * 8192), 16, 0, 0); \
  } while (0)
#define G_LDA(dst, b, h)                                                                                                    \
  do {                                                                                                                      \
    _Pragma("unroll") for (int m = 0; m < 4; ++m) _Pragma("unroll") for (int k = 0; k < 2; ++k) dst[m][k] =                 \
        *(const LAS h16x8*)(lds + G_SA(b, h) + aoff + m * 2048 + k * 1024);                                                 \
  } while (0)
#define G_LDB(dst, b, h)                                                                                                    \
  do {                                                                                                                      \
    _Pragma("unroll") for (int n = 0; n < 2; ++n) _Pragma("unroll") for (int k = 0; k < 2; ++k) dst[n][k] =                 \
        *(const LAS h16x8*)(lds + G_SB(b, h) + boff + n * 2048 + k * 1024);                                                 \
  } while (0)
#define G_MMA(ai, bj, At_, Bt_)                                                                                             \
  do {                                                                                                                      \
    __builtin_amdgcn_s_setprio(1);                                                                                          \
    _Pragma("unroll") for (int m = 0; m < 4; ++m) _Pragma("unroll") for (int n = 0; n < 2; ++n)                             \
    _Pragma("unroll") for (int k = 0; k < 2; ++k) acc[ai][bj][m][n] =                                                       \
        __builtin_amdgcn_mfma_f32_16x16x32_f16(Bt_[n][k], At_[m][k], acc[ai][bj][m][n], 0, 0, 0);                           \
    __builtin_amdgcn_s_setprio(0);                                                                                          \
  } while (0)
#define G_WAIT_V(n) asm volatile("s_waitcnt vmcnt(" #n ")" ::: "memory")
#define G_WAIT_L(n) asm volatile("s_waitcnt lgkmcnt(" #n ")" ::: "memory")
#define G_BAR __builtin_amdgcn_s_barrier()
#define G_SCHED __builtin_amdgcn_sched_barrier(0)
#define G_ZERO                                                                                       \
  _Pragma("unroll") for (int a = 0; a < 2; ++a) _Pragma("unroll") for (int b = 0; b < 2; ++b)        \
  _Pragma("unroll") for (int m = 0; m < 4; ++m) _Pragma("unroll") for (int n = 0; n < 2; ++n) acc[a][b][m][n] = f32x4{0.f, 0.f, 0.f, 0.f}
  Unit cur, nxt;
  int ui = 0;
  if (!S.next(0, cur)) return;
  f32x4 acc[2][2][4][2];
  G_ZERO;
  h16x8 At[4][2], B0[2][2], B1[2][2];
  const char* cA = cur.A;
  const char* cB = cur.B;
  G_STAGE(G_SB(0, 0), cB, voffB); G_STAGE(G_SA(0, 0), cA, voffA); G_STAGE(G_SB(0, 1), cB + hstepB, voffB); G_STAGE(G_SA(0, 1), cA + hstepA, voffA);
  if (wr == 1) G_BAR;
  G_WAIT_V(4); G_BAR;
  G_STAGE(G_SB(1, 0), cB + kstep, voffB); G_STAGE(G_SA(1, 0), cA + kstep, voffA); G_STAGE(G_SB(1, 1), cB + hstepB + kstep, voffB);
  G_WAIT_V(6); G_BAR;
  for (;;) {
    const typename Epi::Pre pre = E.prefetch(cur, wr, fr);
    const bool has_next = S.next(ui + 1, nxt);
    const char* nA = has_next ? nxt.A : cA;
    const char* nB = has_next ? nxt.B : cB;
    for (int t = 0; t < nt; t += 2) {
      const bool last = (t == nt - 2);
      const char* a1 = cA + (size_t)(t + 1) * kstep;
      const char* a2 = last ? nA : cA + (size_t)(t + 2) * kstep;
      const char* b2 = last ? nB : cB + (size_t)(t + 2) * kstep;
      const char* a3 = a2 + kstep;
      const char* b3 = b2 + kstep;
      G_LDB(B0, 0, 0); G_SCHED; G_LDA(At, 0, 0); G_STAGE(G_SA(1, 1), a1 + hstepA, voffA);
      G_WAIT_L(8); G_BAR; G_WAIT_L(0); G_MMA(0, 0, At, B0); G_BAR; G_SCHED;
      G_LDB(B1, 0, 1); G_STAGE(G_SB(0, 0), b2, voffB);
      G_BAR; G_WAIT_L(0); G_MMA(0, 1, At, B1); G_BAR;
      G_LDA(At, 0, 1); G_STAGE(G_SA(0, 0), a2, voffA);
      G_BAR; G_WAIT_L(0); G_MMA(1, 0, At, B0); G_BAR; G_SCHED;
      G_STAGE(G_SB(0, 1), b2 + hstepB, voffB);
      G_WAIT_V(6); G_BAR; G_MMA(1, 1, At, B1); G_BAR;
      G_LDB(B0, 1, 0); G_SCHED; G_LDA(At, 1, 0); G_STAGE(G_SA(0, 1), a2 + hstepA, voffA);
      G_WAIT_L(8); G_BAR; G_WAIT_L(0); G_MMA(0, 0, At, B0); G_BAR; G_SCHED;
      G_LDB(B1, 1, 1); G_STAGE(G_SB(1, 0), b3, voffB);
      G_BAR; G_WAIT_L(0); G_MMA(0, 1, At, B1); G_BAR;
      G_LDA(At, 1, 1); G_STAGE(G_SA(1, 0), a3, voffA);
      G_BAR; G_WAIT_L(0); G_MMA(1, 0, At, B0); G_BAR; G_SCHED;
      G_STAGE(G_SB(1, 1), b3 + hstepB, voffB);
      G_WAIT_V(6); G_BAR; G_MMA(1, 1, At, B1); G_BAR;
    }
    int fr_o = fr, fq_o = fq;
    asm volatile("" : "+v"(fr_o), "+v"(fq_o));
    const bool clr = E(acc, cur, pre, wr, wc, fr_o, fq_o);
    if (!has_next) break;
    if (clr) { G_ZERO; }
    cur = nxt; cA = nA; cB = nB; ++ui;
  }
  G_WAIT_V(0);
  if (wr == 0) G_BAR;
  G_BAR;
}

struct SchedTiles {
  const char *A, *B; size_t tstepA, tstepB; int nN, total, G, c;
  __device__ __forceinline__ bool next(int i, Unit& u) const {
    const long L = (long)i * G + c;
    if (L >= total) return false;
    tile_map((int)L, total, nN, u.pm, u.pn);
    u.A = A + (size_t)u.pm * tstepA; u.B = B + (size_t)u.pn * tstepB; u.seg = 0;
    return true;
  }
};
struct SchedMerge {
  const char *proj, *wl; int G, c;
  __device__ __forceinline__ bool next(int i, Unit& u) const {
    const int tile = (i >> 2) * G + c;
    if (tile >= 256) return false;
    const int seg = i & 3;
    tile_map(tile, 256, 4, u.pm, u.pn);
    const int acol = seg == 0 ? CQ : seg == 1 ? CGU : seg == 2 ? CZ : CZ + 512;
    const long bo = seg == 0 ? O_UPA : seg == 1 ? O_UPB : seg == 2 ? O_UPC : O_UPC + 524288;
    u.A = proj + ((size_t)u.pm * 256 * LDP + acol) * 2;
    u.B = wl + ((size_t)bo + (size_t)u.pn * 256 * 512) * 2;
    u.seg = seg;
    return true;
  }
};

#define FOR_ROWS _Pragma("unroll") for (int ai = 0; ai < 2; ++ai) _Pragma("unroll") for (int m = 0; m < 4; ++m)
__device__ __forceinline__ h16x8 pack8(f32x4 a, f32x4 b) {
  h16x8 r = {(h16)a[0], (h16)a[1], (h16)a[2], (h16)a[3], (h16)b[0], (h16)b[1], (h16)b[2], (h16)b[3]};
  return r;
}

struct EpiInproj {
  h16* proj; float* dtbuf; const float* rss;
  struct Pre { float v[8]; };
  __device__ __forceinline__ Pre prefetch(const Unit& u, int wr, int fr) const {
    Pre q;
    const int row0 = u.pm * 256 + wr * 64 + fr;
#pragma unroll
    for (int r8 = 0; r8 < 8; ++r8) q.v[r8] = rss[row0 + (r8 >> 2) * 128 + (r8 & 3) * 16];
    return q;
  }
  __device__ __forceinline__ bool operator()(f32x4 (&acc)[2][2][4][2], const Unit& u, const Pre& pre, int wr, int wc, int fr, int fq) const {
    const int row0 = u.pm * 256 + wr * 64 + fr, col0 = u.pn * 256 + wc * 32 + 8 * fq;
    FOR_ROWS {
      const size_t row = row0 + ai * 128 + m * 16;
      const float rs = rsqrtf(pre.v[ai * 4 + m] * (1.f / 1024.f) + EPS);
      h16* rp = proj + row * LDP + col0;
#pragma unroll
      for (int bj = 0; bj < 2; ++bj) {
        const int col = col0 + bj * 128;
        if (col < LDP) {
          f32x4 v0 = acc[ai][bj][m][0] * rs, v1 = acc[ai][bj][m][1] * rs;
          if (col >= CG) {
#pragma unroll
            for (int j = 0; j < 4; ++j) {
              v0[j] = fmaxf(__builtin_amdgcn_rcpf(1.f + __expf(-v0[j])), 6.2e-5f);
              v1[j] = fmaxf(__builtin_amdgcn_rcpf(1.f + __expf(-v1[j])), 6.2e-5f);
            }
          }
          *(h16x8*)(rp + bj * 128) = pack8(v0, v1);
          if (col >= CDT && col < CDT + 32) {
            *(f32x4*)(dtbuf + row * 32 + (col - CDT)) = v0;
            *(f32x4*)(dtbuf + row * 32 + (col - CDT) + 4) = v1;
          }
        }
      }
    }
    return true;
  }
};

__device__ __forceinline__ float sig_ratio(float a, float b) {
  a = clampf(a, -30.f, 30.f);
  b = clampf(b, -30.f, 30.f);
  return (1.f + __expf(-b)) / (1.f + __expf(-a));
}
struct EpiMerge {
  const h16* proj; h16* dst; const float* ssq;
  struct Pre {};
  __device__ __forceinline__ Pre prefetch(const Unit&, int, int) const { return Pre{}; }
  __device__ __forceinline__ bool operator()(f32x4 (&acc)[2][2][4][2], const Unit& u, const Pre& pre, int wr, int wc, int fr, int fq) const {
    const int row0 = u.pm * 256 + wr * 64 + fr, col0 = u.pn * 256 + wc * 32 + 8 * fq;
    const int seg = u.seg;
    const int go = (seg == 3) ? 2048 : seg * 1024;
    const h16x8 one = {1, 1, 1, 1, 1, 1, 1, 1};
    float2 sq[8];
#pragma unroll
    for (int r8 = 0; r8 < 8; ++r8) sq[r8] = *(const float2*)(ssq + (size_t)(row0 + (r8 >> 2) * 128 + (r8 & 3) * 16) * 2);
    h16x8 c0[2] = {one, one}, c1[2] = {one, one}, n0[2] = {one, one}, n1[2] = {one, one};
    {
      const h16* gp = proj + (size_t)row0 * LDP + CG + col0 + go;
      if (seg != 2) { c0[0] = *(const h16x8*)gp; c0[1] = *(const h16x8*)(gp + 128); }
      if (seg < 2) { c1[0] = *(const h16x8*)(gp + 1024); c1[1] = *(const h16x8*)(gp + 1024 + 128); }
    }
#pragma unroll
    for (int r8 = 0; r8 < 8; ++r8) {
      const int ai = r8 >> 2, m = r8 & 3;
      const size_t row = row0 + ai * 128 + m * 16;
      if (r8 < 7) {
        const h16* gp = proj + (size_t)(row0 + ((r8 + 1) >> 2) * 128 + ((r8 + 1) & 3) * 16) * LDP + CG + col0 + go;
        if (seg != 2) { n0[0] = *(const h16x8*)gp; n0[1] = *(const h16x8*)(gp + 128); }
        if (seg < 2) { n1[0] = *(const h16x8*)(gp + 1024); n1[1] = *(const h16x8*)(gp + 1024 + 128); }
      }
      const float q0 = sq[r8].x * (1.f / 512.f) + EPS, q1 = sq[r8].y * (1.f / 512.f) + EPS;
      const float f = (seg == 0) ? 1.f : (seg == 1) ? sqrtf(q0) : (seg == 2) ? rsqrtf(q0) * sqrtf(q1) : rsqrtf(q1);
#pragma unroll
      for (int bj = 0; bj < 2; ++bj) {
#pragma unroll
        for (int j = 0; j < 4; ++j) {
          acc[ai][bj][m][0][j] *= (float)c0[bj][j] * __builtin_amdgcn_rcpf((float)c1[bj][j]) * f;
          acc[ai][bj][m][1][j] *= (float)c0[bj][4 + j] * __builtin_amdgcn_rcpf((float)c1[bj][4 + j]) * f;
        }
        if (seg == 3) *(h16x8*)(dst + row * 1024 + col0 + bj * 128) = pack8(acc[ai][bj][m][0], acc[ai][bj][m][1]);
      }
#pragma unroll
      for (int k = 0; k < 2; ++k) { c0[k] = n0[k]; c1[k] = n1[k]; }
    }
    return seg == 3;
  }
};

struct EpiResid {
  float* xo; h16* copy; float* rss; int feed;
  struct Pre {};
  __device__ __forceinline__ Pre prefetch(const Unit&, int, int) const { return Pre{}; }
  __device__ __forceinline__ bool operator()(f32x4 (&acc)[2][2][4][2], const Unit& u, const Pre& pre, int wr, int wc, int fr, int fq) const {
    const int row0 = u.pm * 256 + wr * 64 + fr, col0 = u.pn * 256 + wc * 32 + 8 * fq;
    f32x4 cur[4], nxt[4];
    {
      const float* xp = xo + (size_t)row0 * 1024 + col0;
      cur[0] = *(const f32x4*)xp; cur[1] = *(const f32x4*)(xp + 4); cur[2] = *(const f32x4*)(xp + 128); cur[3] = *(const f32x4*)(xp + 132);
    }
#pragma unroll
    for (int r8 = 0; r8 < 8; ++r8) {
      const int ai = r8 >> 2, m = r8 & 3;
      const size_t row = row0 + ai * 128 + m * 16;
      if (r8 < 7) {
        const float* xp = xo + (size_t)(row0 + ((r8 + 1) >> 2) * 128 + ((r8 + 1) & 3) * 16) * 1024 + col0;
        nxt[0] = *(const f32x4*)xp; nxt[1] = *(const f32x4*)(xp + 4); nxt[2] = *(const f32x4*)(xp + 128); nxt[3] = *(const f32x4*)(xp + 132);
      }
      float ss = 0.f;
#pragma unroll
      for (int bj = 0; bj < 2; ++bj) {
        float* xp = xo + row * 1024 + col0 + bj * 128;
        f32x4 v0 = cur[bj * 2] + acc[ai][bj][m][0], v1 = cur[bj * 2 + 1] + acc[ai][bj][m][1];
        *(f32x4*)xp = v0;
        *(f32x4*)(xp + 4) = v1;
        if (feed) *(h16x8*)(copy + row * 1024 + col0 + bj * 128) = pack8(v0, v1);
#pragma unroll
        for (int j = 0; j < 4; ++j) ss += v0[j] * v0[j] + v1[j] * v1[j];
      }
      ss += __shfl_xor(ss, 16, 64);
      ss += __shfl_xor(ss, 32, 64);
      if (fq == 0 && feed) atomicAdd(rss + row, ss);
#pragma unroll
      for (int k = 0; k < 4; ++k) cur[k] = nxt[k];
    }
    return true;
  }
};

struct EpiFF1 {
  h16* hid; const float* rss;
  struct Pre { float v[8]; };
  __device__ __forceinline__ Pre prefetch(const Unit& u, int wr, int fr) const {
    Pre q;
    const int row0 = u.pm * 256 + wr * 64 + fr;
#pragma unroll
    for (int r8 = 0; r8 < 8; ++r8) q.v[r8] = rss[row0 + (r8 >> 2) * 128 + (r8 & 3) * 16];
    return q;
  }
  __device__ __forceinline__ bool operator()(f32x4 (&acc)[2][2][4][2], const Unit& u, const Pre& pre, int wr, int wc, int fr, int fq) const {
    const int row0 = u.pm * 256 + wr * 64 + fr, col0 = u.pn * 256 + wc * 32 + 8 * fq;
    FOR_ROWS {
      const size_t row = row0 + ai * 128 + m * 16;
      const float rs = rsqrtf(pre.v[ai * 4 + m] * (1.f / 1024.f) + EPS);
#pragma unroll
      for (int bj = 0; bj < 2; ++bj) {
        f32x4 v0 = acc[ai][bj][m][0] * rs, v1 = acc[ai][bj][m][1] * rs;
#pragma unroll
        for (int j = 0; j < 4; ++j) {
          float a = fmaxf(v0[j], 0.f), b = fmaxf(v1[j], 0.f);
          v0[j] = a * a; v1[j] = b * b;
        }
        *(h16x8*)(hid + row * LDH + col0 + bj * 128) = pack8(v0, v1);
      }
    }
    return true;
  }
};

__device__ __forceinline__ void zero_f32(float* p, int n) {
  CTX;
  for (int i = BIDX * 512 + TIDX; i < n; i += gridDim.x * 512) p[i] = 0.f;
}

__device__ void phase_inproj(const Params& p, int l, char* shm) {
  CTX;
  zero_f32(p.rssH, TG);
  SchedTiles S{(const char*)p.bufA, (const char*)(p.wt + (size_t)l * WL + O_WIN), (size_t)256 * 1024 * 2, (size_t)256 * 1024 * 2, 30, 64 * 30, (int)gridDim.x, (int)BIDX};
  EpiInproj E{p.proj, p.dtbuf, p.rssX};
  gemm_phase((LAS unsigned char*)shm, 1024, 1024, 16, S, E);
}
__device__ void phase_merge(const Params& p, int l, char* shm) {
  CTX;
  SchedMerge S{(const char*)p.proj, (const char*)(p.wt + (size_t)l * WL), (int)gridDim.x, (int)BIDX};
  EpiMerge E{p.proj, p.bufA, p.ssq};
  gemm_phase((LAS unsigned char*)shm, LDP, 512, 8, S, E);
}
__device__ void phase_wout(const Params& p, int g, int l, char* shm) {
  CTX;
  SchedTiles S{(const char*)p.bufA, (const char*)(p.wt + (size_t)l * WL + O_WOUT), (size_t)256 * 1024 * 2, (size_t)256 * 1024 * 2, 4, 256, (int)gridDim.x, (int)BIDX};
  EpiResid E{p.out + (size_t)g * TG * 1024, p.bufB, p.rssH, 1};
  gemm_phase((LAS unsigned char*)shm, 1024, 1024, 16, S, E);
}
__device__ void phase_ff1(const Params& p, int l, char* shm) {
  CTX;
  zero_f32(p.rssX, TG);
  SchedTiles S{(const char*)p.bufB, (const char*)(p.wt + (size_t)l * WL + O_FF1), (size_t)256 * 1024 * 2, (size_t)256 * 1024 * 2, 16, 64 * 16, (int)gridDim.x, (int)BIDX};
  EpiFF1 E{p.proj, p.rssH};
  gemm_phase((LAS unsigned char*)shm, 1024, 1024, 16, S, E);
}
__device__ void phase_ff2(const Params& p, int g, int l, char* shm) {
  CTX;
  SchedTiles S{(const char*)p.proj, (const char*)(p.wt + (size_t)l * WL + O_FF2), (size_t)256 * LDH * 2, (size_t)256 * LDH * 2, 4, 256, (int)gridDim.x, (int)BIDX};
  EpiResid E{p.out + (size_t)g * TG * 1024, p.bufA, p.rssX, l < NLAYER - 1};
  gemm_phase((LAS unsigned char*)shm, LDH, LDH, 64, S, E);
}

__device__ __forceinline__ int t5_bucket(int rel) {
  int ret = rel > 0 ? 16 : 0;
  int n = rel < 0 ? -rel : rel;
  if (n < 8) return ret + n;
  int large = 8;
#pragma unroll
  for (int k = 1; k <= 7; ++k) large += (n * n >= (64 << k)) ? 1 : 0;
  return ret + min(large, 15);
}

__device__ void phase_attn(const Params& p, int g, int l, char* shm, int dry) {
  CTX;
  const int S = (g < 2) ? 2048 : 8192;
  constexpr int KS = 72, KP = 408;
  h16* Ks = (h16*)shm;
  h16* VT = Ks + 384 * KS;
  float* bias_s = (float*)(VT + 64 * KP);
  const int wid = TIDX >> 6, lane = TIDX & 63, fr = lane & 15, fq = lane >> 4;
  const float* kg = p.k_norm_g + l * 64;
  const float* qg = p.q_norm_g + l * 64;
  const int nitems = (TG / 128) * 2;
  for (int item = BIDX; item < nitems; item += gridDim.x) {
    const int hk = item & 1, blk = item >> 1;
    const int t0 = blk * 128, seq = t0 / S, q0 = t0 % S;
#pragma unroll
    for (int i = TIDX; i < 4 * 257; i += 512) {
      int gq = i / 257, rel = i % 257 - 128;
      bias_s[i] = p.rel_bias[t5_bucket(rel) * 8 + hk * 4 + gq];
    }
    const int gq = wid >> 1, hq = hk * 4 + gq;
    h16x8 qa_n, qb_n;
    {
      const h16* qr0 = p.proj + (size_t)(seq * S + q0 + (wid & 1) * 64 + fr) * LDP + CQ + hq * 64;
      qa_n = *(const h16x8*)(qr0 + fq * 8); qb_n = *(const h16x8*)(qr0 + 32 + fq * 8);
    }
    float qgA[8], qgB[8];
#pragma unroll
    for (int j = 0; j < 8; ++j) { qgA[j] = qg[fq * 8 + j]; qgB[j] = qg[32 + fq * 8 + j]; }
    for (int i = TIDX; i < 64 * 24; i += 512) VT[(i / 24) * KP + 384 + (i % 24)] = (h16)0.f;
    {
      h16x8 kvr[6], vvr[6];
#pragma unroll
      for (int k = 0; k < 6; ++k) {
        int task = TIDX + k * 512, r = task >> 3, c = (task & 7) * 8;
        int kp = q0 - 128 + r;
        const h16x8 zero = {0, 0, 0, 0, 0, 0, 0, 0};
        const bool valid = (kp >= 0) && (kp < S);
        const h16* rp = p.proj + (size_t)(seq * S + min(max(kp, 0), S - 1)) * LDP;
        kvr[k] = *(const h16x8*)(rp + CK + hk * 64 + c);
        vvr[k] = *(const h16x8*)(rp + CV + hk * 64 + c);
        kvr[k] = valid ? kvr[k] : zero;
        vvr[k] = valid ? vvr[k] : zero;
      }
#pragma unroll
      for (int k = 0; k < 6; ++k) {
        int task = TIDX + k * 512, r = task >> 3, c = (task & 7) * 8;
        float kf[8], ss = 0.f;
#pragma unroll
        for (int j = 0; j < 8; ++j) { kf[j] = (float)kvr[k][j]; ss += kf[j] * kf[j]; }
        ss += __shfl_xor(ss, 1, 64);
        ss += __shfl_xor(ss, 2, 64);
        ss += __shfl_xor(ss, 4, 64);
        float rs = rsqrtf(ss * (1.f / 64.f) + EPS);
        h16x8 kn;
#pragma unroll
        for (int j = 0; j < 8; ++j) { kn[j] = (h16)(kf[j] * rs * kg[c + j]); VT[(c + j) * KP + r] = vvr[k][j]; }
        *(h16x8*)(Ks + r * KS + c) = kn;
      }
    }
    __syncthreads();
    const bool edge = (q0 == 0) || (q0 == S - 128);
    const float sinkv = p.attn_sink[l * 8 + hq];
#pragma unroll 1
    for (int qi = 0; qi < 4; ++qi) {
      const int qt = (wid & 1) * 4 + qi, i = qt * 16 + fr;
      h16* qrow = p.proj + (size_t)(seq * S + q0 + i) * LDP + CQ + hq * 64;
      h16x8 qa = qa_n, qb = qb_n;
      if (qi < 3) {
        const h16* qrn = qrow + (size_t)16 * LDP;
        qa_n = *(const h16x8*)(qrn + fq * 8); qb_n = *(const h16x8*)(qrn + 32 + fq * 8);
      }
      {
        float ss = 0.f;
#pragma unroll
        for (int j = 0; j < 8; ++j) ss += (float)qa[j] * (float)qa[j] + (float)qb[j] * (float)qb[j];
        ss += __shfl_xor(ss, 16, 64);
        ss += __shfl_xor(ss, 32, 64);
        const float rs = rsqrtf(ss * (1.f / 64.f) + EPS) * 0.125f;
#pragma unroll
        for (int j = 0; j < 8; ++j) {
          qa[j] = (h16)((float)qa[j] * rs * qgA[j]);
          qb[j] = (h16)((float)qb[j] * rs * qgB[j]);
        }
      }
      f32x4 sc[18];
#pragma unroll
      for (int kt = 0; kt < 17; ++kt) {
        const h16* kr = Ks + ((qt + kt) * 16 + fr) * KS + fq * 8;
        f32x4 acc = {0.f, 0.f, 0.f, 0.f};
        acc = __builtin_amdgcn_mfma_f32_16x16x32_f16(*(const h16x8*)kr, qa, acc, 0, 0, 0);
        acc = __builtin_amdgcn_mfma_f32_16x16x32_f16(*(const h16x8*)(kr + 32), qb, acc, 0, 0, 0);
        sc[kt] = acc;
      }
      sc[17] = f32x4{0.f, 0.f, 0.f, 0.f};
      float mx = sinkv;
      const int d0 = 4 * fq - fr;
      const float* bl = bias_s + gq * 257 + d0;
      if (!edge) {
#pragma unroll
        for (int kt = 0; kt < 17; ++kt) {
#pragma unroll
          for (int j = 0; j < 4; ++j) {
            const int rel = kt * 16 + d0 + j;
            float s;
            if (kt == 0) s = (rel >= 0) ? sc[kt][j] + bl[max(j, -d0)] : -1e30f;
            else if (kt == 16) s = (rel <= 256) ? sc[kt][j] + bl[min(256 + j, 256 - d0)] : -1e30f;
            else s = sc[kt][j] + bl[kt * 16 + j];
            sc[kt][j] = s;
            mx = fmaxf(mx, s);
          }
        }
      } else {
#pragma unroll
        for (int kt = 0; kt < 17; ++kt) {
#pragma unroll
          for (int j = 0; j < 4; ++j) {
            const int r = (qt + kt) * 16 + 4 * fq + j, rel = r - i, kp = q0 - 128 + r;
            const bool valid = (rel >= 0) && (rel <= 256) && (kp >= 0) && (kp < S);
            const float s = valid ? sc[kt][j] + bias_s[gq * 257 + min(max(rel, 0), 256)] : -1e30f;
            sc[kt][j] = s;
            mx = fmaxf(mx, s);
          }
        }
      }
      mx = fmaxf(mx, __shfl_xor(mx, 16, 64));
      mx = fmaxf(mx, __shfl_xor(mx, 32, 64));
      float sum = 0.f;
#pragma unroll
      for (int kt = 0; kt < 17; ++kt) {
#pragma unroll
        for (int j = 0; j < 4; ++j) { float pe = __expf(sc[kt][j] - mx); sc[kt][j] = pe; sum += pe; }
      }
      sum += __shfl_xor(sum, 16, 64);
      sum += __shfl_xor(sum, 32, 64);
      sum += __expf(sinkv - mx);
      const float inv = 1.f / sum;
      h16x8 pb[9];
#pragma unroll
      for (int u = 0; u < 9; ++u) {
#pragma unroll
        for (int j = 0; j < 4; ++j) { pb[u][j] = (h16)sc[2 * u][j]; pb[u][4 + j] = (h16)sc[2 * u + 1][j]; }
      }
#pragma unroll
      for (int dt = 0; dt < 4; ++dt) {
        f32x4 acc = {0.f, 0.f, 0.f, 0.f};
        const h16* vr = VT + (dt * 16 + fr) * KP + qt * 16 + 4 * fq;
#pragma unroll
        for (int u = 0; u < 9; ++u) {
          h16x4 va = *(const h16x4*)(vr + u * 32), vb = *(const h16x4*)(vr + u * 32 + 16);
          h16x8 a = {va[0], va[1], va[2], va[3], vb[0], vb[1], vb[2], vb[3]};
          acc = __builtin_amdgcn_mfma_f32_16x16x32_f16(a, pb[u], acc, 0, 0, 0);
        }
        h16x4 ov = {(h16)(acc[0] * inv), (h16)(acc[1] * inv), (h16)(acc[2] * inv), (h16)(acc[3] * inv)};
        if (!dry) *(h16x4*)(qrow + dt * 16 + 4 * fq) = ov;
      }
    }
    __syncthreads();
  }
}

__device__ void phase_gmlp(const Params& p, int l, char* shm, int dry) {
  CTX;
  constexpr int GP = 136;
  h16* vnT = (h16*)shm;
  h16* Ws = vnT + 128 * GP;
  float* mean_s = (float*)(Ws + 128 * GP);
  float* rstd_s = mean_s + 128;
  const int wid = TIDX >> 6, lane = TIDX & 63, fr = lane & 15, fq = lane >> 4;
  const float* lng = p.gmlp_ln_g + l * 512;
  const float* lnb = p.gmlp_ln_b + l * 512;
  const int nitems = (TG / 128) * 2;
  for (int item = BIDX; item < nitems; item += gridDim.x) {
    const int half = item & 1, t0 = (item >> 1) * 128;
    const int row = TIDX >> 2, part = TIDX & 3;
    const h16* rp = p.proj + (size_t)(t0 + row) * LDP + CGV;
    {
      float sum = 0.f, sq = 0.f;
#pragma unroll
      for (int c = 0; c < 128; c += 8) {
        h16x8 v = *(const h16x8*)(rp + c * 4 + part * 8);
#pragma unroll
        for (int j = 0; j < 8; ++j) { float ge = gelu_t((float)v[j]); sum += ge; sq += ge * ge; }
      }
      sum += __shfl_xor(sum, 1, 64); sum += __shfl_xor(sum, 2, 64);
      sq += __shfl_xor(sq, 1, 64); sq += __shfl_xor(sq, 2, 64);
      float mean = sum * (1.f / 512.f);
      float var = fmaxf(sq * (1.f / 512.f) - mean * mean, 0.f);
      if (part == 0) { mean_s[row] = mean; rstd_s[row] = rsqrtf(var + EPS); }
    }
#pragma unroll 1
    for (int gi = 0; gi < 2; ++gi) {
      const int grp = half * 2 + gi;
      __syncthreads();
      {
        const float mean = mean_s[row], rstd = rstd_s[row];
#pragma unroll
        for (int c = 0; c < 32; c += 8) {
          int cl = c * 4 + part * 8;
          h16x8 v = *(const h16x8*)(rp + grp * 128 + cl);
#pragma unroll
          for (int j = 0; j < 8; ++j) {
            float ge = gelu_t((float)v[j]);
            vnT[(cl + j) * GP + row] = (h16)((ge - mean) * rstd * lng[grp * 128 + cl + j] + lnb[grp * 128 + cl + j]);
          }
        }
        const h16* w = p.wt + (size_t)l * WL + O_WSP + grp * 16384;
#pragma unroll
        for (int k = 0; k < 4; ++k) {
          int e = (TIDX + k * 512) * 8, tt = e >> 7, s0 = e & 127;
          *(h16x8*)(Ws + tt * GP + s0) = *(const h16x8*)(w + e);
        }
      }
      __syncthreads();
      const int t = wid * 16 + fr;
      h16x8 bfrag[4];
#pragma unroll
      for (int ks = 0; ks < 4; ++ks) bfrag[ks] = *(const h16x8*)(Ws + t * GP + ks * 32 + fq * 8);
      const float bsv = p.b_spatial[(size_t)l * 512 + grp * 128 + t];
      h16* ubase = p.proj + (size_t)(t0 + t) * LDP + CGU + grp * 128 + 4 * fq;
      h16x4 uvs[8];
#pragma unroll
      for (int et = 0; et < 8; ++et) uvs[et] = *(const h16x4*)(ubase + et * 16);
#pragma unroll
      for (int et = 0; et < 8; ++et) {
        f32x4 acc = {0.f, 0.f, 0.f, 0.f};
#pragma unroll
        for (int ks = 0; ks < 4; ++ks)
          acc = __builtin_amdgcn_mfma_f32_16x16x32_f16(*(const h16x8*)(vnT + (et * 16 + fr) * GP + ks * 32 + fq * 8), bfrag[ks], acc, 0, 0, 0);
        h16* up = ubase + et * 16;
        h16x4 uv = uvs[et], ov;
#pragma unroll
        for (int j = 0; j < 4; ++j) ov[j] = (h16)(gelu_t((float)uv[j]) * (acc[j] + bsv));
        if (!dry) *(h16x4*)up = ov;
      }
    }
    __syncthreads();
  }
}

constexpr int SP = 136;
struct Raw3 { h16x8 p, c, n; };
__device__ __forceinline__ Raw3 conv_load(const h16* rp, bool hp, bool hn) {
  const h16x8 zero = {0, 0, 0, 0, 0, 0, 0, 0};
  Raw3 r;
  r.c = *(const h16x8*)rp;
  r.p = *(const h16x8*)(hp ? rp - LDP : rp);
  r.n = *(const h16x8*)(hn ? rp + LDP : rp);
  r.p = hp ? r.p : zero;
  r.n = hn ? r.n : zero;
  return r;
}
__device__ __forceinline__ void conv_apply(const Raw3& r, const float4* __restrict__ cwS, float (&o)[8]) {
#pragma unroll
  for (int j = 0; j < 8; ++j) {
    const float4 w = cwS[j];
    float v = w.w + (float)r.p[j] * w.x + (float)r.c[j] * w.y + (float)r.n[j] * w.z;
    o[j] = silu_f(v);
  }
}
__device__ __forceinline__ void ssd_dt_cum(const Params& p, int l, int t0, int grp, float* dts, float* cums, int TIDX) {
#pragma unroll
  for (int i = TIDX; i < 2048; i += 512) {
    int tok = i >> 4, j = i & 15, col = (j >> 3) * 16 + grp * 8 + (j & 7);
    float v = p.dtbuf[(size_t)(t0 + tok) * 32 + col] + p.dt_bias[l * 32 + col];
    dts[j * 128 + tok] = (v > 20.f) ? v : log1pf(expf(v));
  }
  __syncthreads();
  const int wid = TIDX >> 6, lane = TIDX & 63;
#pragma unroll
  for (int k = 0; k < 2; ++k) {
    const int combo = wid * 2 + k, dir = combo >> 3;
    const float a = -expf(p.a_log[l * 32 + dir * 16 + grp * 8 + (combo & 7)]);
    const int e0 = lane * 2;
    const int ta = dir ? 127 - e0 : e0, tb = dir ? 126 - e0 : e0 + 1;
    float v0 = dts[combo * 128 + ta] * a, v1 = dts[combo * 128 + tb] * a;
    float s = v0 + v1;
#pragma unroll
    for (int o = 1; o < 64; o <<= 1) {
      float n = __shfl_up(s, o, 64);
      if (lane >= o) s += n;
    }
    cums[combo * 128 + tb] = s;
    cums[combo * 128 + ta] = s - v1;
  }
  __syncthreads();
}

__device__ void phase_ssd_state(const Params& p, int g, int l, char* shm) {
  CTX;
  const int S = (g < 2) ? 2048 : 8192;
  h16* BT = (h16*)shm;
  h16* XT = BT + 128 * SP;
  float* dts = (float*)(XT + 64 * SP);
  float* cums = dts + 2048;
  h16* wv = (h16*)(cums + 2048);
  float4* cwS = (float4*)(wv + 2048);
  const int wid = TIDX >> 6, lane = TIDX & 63, fr = lane & 15, fq = lane >> 4;
  const float* cw = p.conv_w + (size_t)l * 4608;
  const float* cb = p.conv_b + (size_t)l * 1536;
  for (int item = BIDX; item < 256; item += gridDim.x) {
    const int grp = item & 1, ch = item >> 1, t0 = ch * 128, tl0 = t0 & (S - 1);
#pragma unroll
    for (int i = TIDX; i < 640; i += 512) {
      int c = (i < 128) ? 1024 + grp * 128 + i : grp * 512 + (i - 128);
      cwS[i] = float4{cw[c], cw[1536 + c], cw[3072 + c], cb[c]};
    }
    const int cs = TIDX & 127, cc8 = (TIDX >> 7) * 8;
    const bool hp = tl0 + cs > 0, hn = tl0 + cs < S - 1;
    const h16* xrow = p.proj + (size_t)(t0 + cs) * LDP + CX;
    Raw3 br[4];
#pragma unroll
    for (int k = 0; k < 4; ++k) br[k] = conv_load(xrow + 1024 + grp * 128 + cc8 + k * 32, hp, hn);
    Raw3 xr[2];
#pragma unroll
    for (int k = 0; k < 2; ++k) xr[k] = conv_load(xrow + grp * 512 + cc8 + k * 32, hp, hn);
    ssd_dt_cum(p, l, t0, grp, dts, cums, TIDX);
#pragma unroll
    for (int i = TIDX; i < 2048; i += 512) {
      int combo = i >> 7;
      float cend = cums[combo * 128 + ((combo >> 3) ? 0 : 127)];
      wv[i] = (h16)(__expf(cend - cums[i]) * dts[i]);
    }
    if (TIDX < 16) p.dec[(ch * 2 + grp) * 16 + TIDX] = __expf(cums[TIDX * 128 + ((TIDX >> 3) ? 0 : 127)]);
#pragma unroll
    for (int k = 0; k < 4; ++k) {
      float o[8];
      conv_apply(br[k], cwS + cc8 + k * 32, o);
#pragma unroll
      for (int j = 0; j < 8; ++j) BT[(cc8 + k * 32 + j) * SP + cs] = (h16)o[j];
    }
    __syncthreads();
    h16x8 af[4];
#pragma unroll
    for (int ks = 0; ks < 4; ++ks) af[ks] = *(const h16x8*)(BT + (wid * 16 + fr) * SP + ks * 32 + fq * 8);
#pragma unroll 1
    for (int hh = 0; hh < 8; ++hh) {
      __syncthreads();
#pragma unroll
      for (int k = 0; k < 2; ++k) {
        float o[8];
        conv_apply(xr[k], cwS + 128 + hh * 64 + cc8 + k * 32, o);
#pragma unroll
        for (int j = 0; j < 8; ++j) XT[(cc8 + k * 32 + j) * SP + cs] = (h16)o[j];
      }
      if (hh < 7) {
#pragma unroll
        for (int k = 0; k < 2; ++k) xr[k] = conv_load(xrow + grp * 512 + (hh + 1) * 64 + cc8 + k * 32, hp, hn);
      }
      __syncthreads();
#pragma unroll
      for (int dir = 0; dir < 2; ++dir) {
        const int combo = dir * 8 + hh;
        h16* stp = p.st + ((((size_t)ch * 2 + grp) * 2 + dir) * 8 + hh) * 8192;
#pragma unroll
        for (int pt = 0; pt < 4; ++pt) {
          f32x4 acc = {0.f, 0.f, 0.f, 0.f};
#pragma unroll
          for (int ks = 0; ks < 4; ++ks) {
            h16x8 xb = *(const h16x8*)(XT + (pt * 16 + fr) * SP + ks * 32 + fq * 8) * *(const h16x8*)(wv + combo * 128 + ks * 32 + fq * 8);
            acc = __builtin_amdgcn_mfma_f32_16x16x32_f16(af[ks], xb, acc, 0, 0, 0);
          }
          h16x4 o4 = {(h16)acc[0], (h16)acc[1], (h16)acc[2], (h16)acc[3]};
          *(h16x4*)(stp + (pt * 16 + fr) * 128 + wid * 16 + 4 * fq) = o4;
        }
      }
    }
    __syncthreads();
  }
}

template <int W>
__device__ __forceinline__ void ssd_scan_body(const Params& p, int g, int dry, int TIDX, int BIDX) {
  typedef _Float16 hv __attribute__((ext_vector_type(W)));
  const int S = (g < 2) ? 2048 : 8192, nc = S / 128, nseq = TG / S;
  constexpr int VPC = 8192 / W;
  const int total = nseq * 32 * VPC;
  for (int idx = BIDX * 512 + TIDX; idx < total; idx += gridDim.x * 512) {
    const int v = idx % VPC, combo = (idx / VPC) & 31, seq = idx / (VPC * 32), dir = (combo >> 3) & 1;
    float carry[W];
#pragma unroll
    for (int j = 0; j < W; ++j) carry[j] = 0.f;
    for (int i = 0; i < nc; i += 8) {
      hv L[8]; float d[8]; h16* ptr[8];
#pragma unroll
      for (int u = 0; u < 8; ++u) {
        int c = dir ? nc - 1 - (i + u) : (i + u);
        int chg = seq * nc + c;
        ptr[u] = p.st + ((size_t)chg * 32 + combo) * 8192 + v * W;
        L[u] = *(const hv*)ptr[u];
        d[u] = p.dec[chg * 32 + combo];
      }
#pragma unroll
      for (int u = 0; u < 8; ++u) {
        hv o;
#pragma unroll
        for (int j = 0; j < W; ++j) { o[j] = (h16)carry[j]; carry[j] = carry[j] * d[u] + (float)L[u][j]; }
        if (!dry) *(hv*)ptr[u] = o;
      }
    }
  }
}
__device__ void phase_ssd_scan(const Params& p, int g, int dry) {
  CTX;
  if (g < 2) ssd_scan_body<8>(p, g, dry, TIDX, BIDX);
  else ssd_scan_body<4>(p, g, dry, TIDX, BIDX);
}

__device__ void phase_ssd_out(const Params& p, int g, int l, char* shm, int dry) {
  CTX;
  const int S = (g < 2) ? 2048 : 8192;
  h16* Cs = (h16*)shm;
  h16* Bs = Cs + 128 * SP;
  h16* Sf = Bs;
  h16* Sb = Bs + 64 * SP;
  h16* XT = Bs + 128 * SP;
  h16* Ms = XT + 64 * SP;
  float* dts = (float*)(Ms + 128 * SP);
  float* cums = dts + 2048;
  float4* cwS = (float4*)(cums + 2048);
  const int wid = TIDX >> 6, lane = TIDX & 63, fr = lane & 15, fq = lane >> 4;
  const float* cw = p.conv_w + (size_t)l * 4608;
  const float* cb = p.conv_b + (size_t)l * 1536;
  for (int item = BIDX; item < 256; item += gridDim.x) {
    const int grp = item & 1, ch = item >> 1, t0 = ch * 128, tl0 = t0 & (S - 1);
#pragma unroll
    for (int i = TIDX; i < 768; i += 512) {
      int c = (i < 128) ? 1024 + grp * 128 + i : (i < 256) ? 1280 + grp * 128 + (i - 128) : grp * 512 + (i - 256);
      cwS[i] = float4{cw[c], cw[1536 + c], cw[3072 + c], cb[c]};
    }
    const int cs = TIDX & 127, cc8 = (TIDX >> 7) * 8;
    const bool hp = tl0 + cs > 0, hn = tl0 + cs < S - 1;
    const h16* xrow = p.proj + (size_t)(t0 + cs) * LDP + CX;
    Raw3 br[4];
#pragma unroll
    for (int k = 0; k < 4; ++k) br[k] = conv_load(xrow + 1024 + grp * 128 + cc8 + k * 32, hp, hn);
    ssd_dt_cum(p, l, t0, grp, dts, cums, TIDX);
#pragma unroll
    for (int k = 0; k < 4; ++k) {
      float o[8];
      conv_apply(br[k], cwS + cc8 + k * 32, o);
      h16x8 ov;
#pragma unroll
      for (int j = 0; j < 8; ++j) ov[j] = (h16)o[j];
      *(h16x8*)(Bs + cs * SP + cc8 + k * 32) = ov;
    }
#pragma unroll
    for (int k = 0; k < 4; ++k) br[k] = conv_load(xrow + 1280 + grp * 128 + cc8 + k * 32, hp, hn);
    Raw3 xr[2];
#pragma unroll
    for (int k = 0; k < 2; ++k) xr[k] = conv_load(xrow + grp * 512 + cc8 + k * 32, hp, hn);
    const int sc8 = (TIDX & 15) * 8;
    const h16* stb = p.st + (((size_t)ch * 2 + grp) * 2) * 8 * 8192;
#pragma unroll
    for (int k = 0; k < 4; ++k) {
      float o[8];
      conv_apply(br[k], cwS + 128 + cc8 + k * 32, o);
      h16x8 ov;
#pragma unroll
      for (int j = 0; j < 8; ++j) ov[j] = (h16)o[j];
      *(h16x8*)(Cs + cs * SP + cc8 + k * 32) = ov;
    }
    __syncthreads();
    const int lcol = wid * 16 + fr;
    f32x4 cbT[8];
#pragma unroll
    for (int st = 0; st < 8; ++st) {
      f32x4 acc = {0.f, 0.f, 0.f, 0.f};
#pragma unroll
      for (int ks = 0; ks < 4; ++ks) {
        h16x8 a = *(const h16x8*)(Bs + (st * 16 + fr) * SP + ks * 32 + fq * 8);
        acc = __builtin_amdgcn_mfma_f32_16x16x32_f16(a, *(const h16x8*)(Cs + lcol * SP + ks * 32 + fq * 8), acc, 0, 0, 0);
      }
      cbT[st] = acc;
    }
    float ssq_acc = 0.f;
    h16* zrow = p.proj + (size_t)(t0 + lcol) * LDP + CZ + grp * 512 + 4 * fq;
#pragma unroll 1
    for (int hh = 0; hh < 8; ++hh) {
      __syncthreads();
      h16x8 sfr[4];
#pragma unroll
      for (int k = 0; k < 4; ++k) {
        int task = TIDX + k * 512, which = task >> 10, r = (task >> 4) & 63;
        sfr[k] = *(const h16x8*)(stb + ((size_t)which * 8 + hh) * 8192 + r * 128 + sc8);
      }
#pragma unroll
      for (int k = 0; k < 2; ++k) {
        float o[8];
        conv_apply(xr[k], cwS + 256 + hh * 64 + cc8 + k * 32, o);
#pragma unroll
        for (int j = 0; j < 8; ++j) XT[(cc8 + k * 32 + j) * SP + cs] = (h16)o[j];
      }
      if (hh < 7) {
#pragma unroll
        for (int k = 0; k < 2; ++k) xr[k] = conv_load(xrow + grp * 512 + (hh + 1) * 64 + cc8 + k * 32, hp, hn);
      }
      h16x4 zv[4];
#pragma unroll
      for (int pt = 0; pt < 4; ++pt) zv[pt] = *(const h16x4*)(zrow + hh * 64 + pt * 16);
      const float cfl = cums[hh * 128 + lcol], cbl = cums[(8 + hh) * 128 + lcol];
#pragma unroll
      for (int st = 0; st < 8; ++st) {
        const int s0 = st * 16 + 4 * fq;
        f32x4 cfs = *(const f32x4*)(cums + hh * 128 + s0), cbs = *(const f32x4*)(cums + (8 + hh) * 128 + s0);
        f32x4 dfs = *(const f32x4*)(dts + hh * 128 + s0), dbs = *(const f32x4*)(dts + (8 + hh) * 128 + s0);
        h16x4 mv;
#pragma unroll
        for (int j = 0; j < 4; ++j) {
          const int s = s0 + j;
          float e = (s <= lcol) ? cfl - cfs[j] : cbl - cbs[j];
          float d = (s <= lcol) ? dfs[j] : dbs[j];
          float v = __expf(e) * d;
          if (s == lcol) v = dfs[j] + dbs[j];
          mv[j] = (h16)(cbT[st][j] * v);
        }
        *(h16x4*)(Ms + lcol * SP + s0) = mv;
      }
#pragma unroll
      for (int k = 0; k < 4; ++k) {
        int task = TIDX + k * 512, which = task >> 10, r = (task >> 4) & 63;
        *(h16x8*)((which ? Sb : Sf) + r * SP + sc8) = sfr[k];
      }
      __syncthreads();
      h16x8 mfrag[4];
#pragma unroll
      for (int ks = 0; ks < 4; ++ks) mfrag[ks] = *(const h16x8*)(Ms + lcol * SP + ks * 32 + fq * 8);
      const float ecf = __expf(cfl), ecb = __expf(cbl), Dk = p.d_skip[l * 16 + grp * 8 + hh];
#pragma unroll
      for (int pt = 0; pt < 4; ++pt) {
        f32x4 aY = {0.f, 0.f, 0.f, 0.f}, aF = aY, aB = aY;
#pragma unroll
        for (int ks = 0; ks < 4; ++ks) {
          const int o = (pt * 16 + fr) * SP + ks * 32 + fq * 8;
          aY = __builtin_amdgcn_mfma_f32_16x16x32_f16(*(const h16x8*)(XT + o), mfrag[ks], aY, 0, 0, 0);
          const h16x8 cf = *(const h16x8*)(Cs + lcol * SP + ks * 32 + fq * 8);
          aF = __builtin_amdgcn_mfma_f32_16x16x32_f16(*(const h16x8*)(Sf + o), cf, aF, 0, 0, 0);
          aB = __builtin_amdgcn_mfma_f32_16x16x32_f16(*(const h16x8*)(Sb + o), cf, aB, 0, 0, 0);
        }
        const int p0 = pt * 16 + 4 * fq;
        h16x4 ov;
#pragma unroll
        for (int j = 0; j < 4; ++j) {
          float x = (float)XT[(p0 + j) * SP + lcol];
          float y = aY[j] + ecf * aF[j] + ecb * aB[j] + Dk * x;
          float gt = y * silu_f((float)zv[pt][j]);
          ssq_acc += gt * gt;
          ov[j] = (h16)gt;
        }
        if (!dry) *(h16x4*)(zrow + hh * 64 + pt * 16) = ov;
      }
    }
    ssq_acc += __shfl_xor(ssq_acc, 16, 64);
    ssq_acc += __shfl_xor(ssq_acc, 32, 64);
    if (fq == 0 && !dry) p.ssq[(size_t)(t0 + lcol) * 2 + grp] = ssq_acc;
    __syncthreads();
  }
}

#define XB_TMO 128
#define XB_XCNT(j) (256 + 64 * (j))
#define XB_XSUB(j) (1280 + 64 * (j))
#define XB_XGEN(j) (2304 + 64 * (j))
#define XB_TOP 3328
#define XB_TOPGEN 3392
#define XCD_BAR_WORDS 3456
#define XB_SPIN_CAP (1u << 20)
__device__ __forceinline__ unsigned xb_ld(unsigned* p) { return __hip_atomic_load(p, __ATOMIC_RELAXED, __HIP_MEMORY_SCOPE_AGENT); }
__device__ __forceinline__ unsigned xb_add(unsigned* p, unsigned v) { return __hip_atomic_fetch_add(p, v, __ATOMIC_RELAXED, __HIP_MEMORY_SCOPE_AGENT); }
__device__ __forceinline__ unsigned xb_xcc_id() { return (unsigned)__builtin_amdgcn_s_getreg((3 << 11) | 20) & 0xFu; }
#define XB_SPIN(cond, bar)                                                                        \
  do {                                                                                            \
    unsigned _sp = 0;                                                                             \
    while (cond) {                                                                                \
      __builtin_amdgcn_s_sleep(1);                                                                \
      if ((++_sp & 255u) == 0u) {                                                                 \
        if (xb_ld(&(bar)[XB_TMO])) break;                                                         \
        if (_sp > XB_SPIN_CAP) { atomicAdd(&(bar)[XB_TMO], 1u); break; }                          \
      }                                                                                           \
    }                                                                                             \
  } while (0)
__device__ __forceinline__ void xcd_barrier_complete(unsigned* bar, unsigned x, unsigned& nloc, unsigned& nx) {
  const unsigned G = gridDim.x;
  unsigned sum, cnt, mine, sp = 0u;
  for (;;) {
    sum = 0u; cnt = 0u; mine = 0u;
#pragma unroll
    for (unsigned j = 0; j < 16; ++j) { const unsigned c = xb_ld(&bar[XB_XCNT(j)]); sum += c; cnt += (c > 0u) ? 1u : 0u; mine = (j == x) ? c : mine; }
    if (sum == G) break;
    __builtin_amdgcn_s_sleep(1);
    if ((++sp & 255u) == 0u) { if (xb_ld(&bar[XB_TMO])) break; if (sp > XB_SPIN_CAP) { atomicAdd(&bar[XB_TMO], 1u); break; } }
  }
  nloc = mine > 0u ? mine : 1u; nx = cnt > 0u ? cnt : 1u;
}
__device__ __forceinline__ void xcd_barrier(unsigned* bar, unsigned x, volatile LAS unsigned* st) {
  asm volatile("s_waitcnt vmcnt(0)" ::: "memory");
  __syncthreads();
  if (threadIdx.x == 0) {
    __builtin_amdgcn_s_waitcnt(0);
    unsigned nloc = st[0], nx = st[1];
    if (nloc == 0u) { xcd_barrier_complete(bar, x, nloc, nx); st[0] = nloc; st[1] = nx; }
    const unsigned old = xb_add(&bar[XB_XSUB(x)], 1u);
    const unsigned gen = old / nloc;
    if (old + 1u == (gen + 1u) * nloc) {
      __builtin_amdgcn_fence(__ATOMIC_RELEASE, "agent");
      asm volatile("s_waitcnt vmcnt(0)" ::: "memory");
      const unsigned og = xb_add(&bar[XB_TOP], 1u);
      const unsigned tg = og / nx;
      if (og + 1u == (tg + 1u) * nx) xb_add(&bar[XB_TOPGEN], 1u);
      else XB_SPIN(xb_ld(&bar[XB_TOPGEN]) == tg, bar);
      __builtin_amdgcn_fence(__ATOMIC_ACQUIRE, "agent");
      xb_add(&bar[XB_XGEN(x)], 1u);
      asm volatile("s_waitcnt vmcnt(0)" ::: "memory");
    } else {
      XB_SPIN(xb_ld(&bar[XB_XGEN(x)]) == gen, bar);
      __builtin_amdgcn_fence(__ATOMIC_ACQUIRE, "agent");
      asm volatile("s_waitcnt vmcnt(0)" ::: "memory");
    }
  }
  __syncthreads();
}

__device__ __forceinline__ unsigned long long rd_tab(const unsigned* tab, int i) {
  unsigned lo = __builtin_amdgcn_readfirstlane(tab[2 * i]), hi = __builtin_amdgcn_readfirstlane(tab[2 * i + 1]);
  return ((unsigned long long)hi << 32) | lo;
}
template <class T> __device__ __forceinline__ T* as_global(unsigned long long v) {
  return (T*)(__attribute__((address_space(1))) T*)v;
}
__device__ __forceinline__ Params load_params(const unsigned* tab) {
  Params q;
#define X(i, T, n) q.n = as_global<std::remove_pointer_t<T>>(rd_tab(tab, i));
  PFIELDS(X)
#undef X
  q.step_lo = 0; q.step_hi = 0;
  return q;
}
#define LP const Params p = load_params(tab)
__device__ void run_step(const unsigned* tab, int s, char* shm) {
  if (s == 0) { { LP; phase_prep(p, shm); } { LP; phase_pre(p, 0); } return; }
  s -= 1;
  const int g = s >> 5, r = s & 31;
  const int l = r >> 3, ph = r & 7;
  switch (ph) {
    case 0: { LP; phase_inproj(p, l, shm); } break;
    case 1:
      if (blockIdx.x & 1) { { LP; phase_gmlp(p, l, shm, 0); } { LP; phase_ssd_state(p, g, l, shm); } }
      else { { LP; phase_ssd_state(p, g, l, shm); } { LP; phase_gmlp(p, l, shm, 0); } }
      break;
    case 2:
      if (blockIdx.x & 1) { { LP; phase_attn(p, g, l, shm, 0); } { LP; phase_ssd_scan(p, g, 0); } }
      else { { LP; phase_ssd_scan(p, g, 0); } { LP; phase_attn(p, g, l, shm, 0); } }
      break;
    case 3: { LP; phase_ssd_out(p, g, l, shm, 0); } break;
    case 4: { LP; phase_merge(p, l, shm); } break;
    case 5: { LP; phase_wout(p, g, l, shm); } break;
    case 6: { LP; phase_ff1(p, l, shm); } break;
    default: { { LP; phase_ff2(p, g, l, shm); } if (l == NLAYER - 1 && g < 2) { LP; phase_pre(p, g + 1); } } break;
  }
}

__global__ void __launch_bounds__(512, 2) mega(Params p) {
  extern __shared__ __attribute__((aligned(16))) char shm[];
  unsigned long long* tab = (unsigned long long*)(shm + SHM_TAB);
  volatile LAS unsigned* bst = (volatile LAS unsigned*)(LAS unsigned*)(shm + SHM_TAB - 16);
  if (threadIdx.x == 0) {
#define X(i, T, n) tab[i] = (unsigned long long)p.n;
    PFIELDS(X)
#undef X
    bst[0] = 0u; bst[1] = 0u;
  }
  const int lo = p.step_lo, hi = p.step_hi;
  unsigned* bar = p.bar;
  const unsigned xcc = xb_xcc_id();
  __syncthreads();
  if (threadIdx.x == 0) (void)xb_add(&bar[XB_XCNT(xcc)], 1u);
  for (int s = lo; s < hi; ++s) {
    if (s > lo) {
      if (s == lo + 1) cg::this_grid().sync();
      else xcd_barrier(as_global<unsigned>(rd_tab((const unsigned*)tab, 36)), xcc, bst);
    }
    run_step((const unsigned*)tab, s, shm);
  }
}

extern "C" void kernel_launch(void* const* d_in, const int* in_sizes, int n_in, void* d_out, int out_size, void* d_ws,
                              size_t ws_size, hipStream_t stream) {
  Params p{};
  {
    const float** fp = (const float**)&p;
    for (int i = 0; i < 25; ++i) fp[i] = (const float*)d_in[i];
  }
  p.out = (float*)d_out;
  char* ws = (char*)d_ws;
  size_t off = 0;
  p.wt = (h16*)(ws + off); off += (size_t)NLAYER * WL * 2;
  p.proj = (h16*)(ws + off); off += (size_t)TG * LDP * 2;
  p.bufA = (h16*)(ws + off); off += (size_t)TG * 1024 * 2;
  p.bufB = (h16*)(ws + off); off += (size_t)TG * 1024 * 2;
  p.st = (h16*)(ws + off); off += (size_t)64 << 20;
  p.rssX = (float*)(ws + off); off += (size_t)TG * 4;
  p.rssH = (float*)(ws + off); off += (size_t)TG * 4;
  p.dtbuf = (float*)(ws + off); off += (size_t)TG * 32 * 4;
  p.dec = (float*)(ws + off); off += (size_t)128 * 32 * 4;
  p.ssq = (float*)(ws + off); off += (size_t)TG * 2 * 4;
  p.bar = (unsigned*)(ws + off); off += (size_t)XCD_BAR_WORDS * 4;
  static int grid_blocks = 0;
  if (!grid_blocks) {
    (void)hipFuncSetAttribute((const void*)mega, hipFuncAttributeMaxDynamicSharedMemorySize, SHM_TOTAL);
    int dev = 0, cus = 0, per_cu = 0;
    (void)hipGetDevice(&dev);
    (void)hipDeviceGetAttribute(&cus, hipDeviceAttributeMultiprocessorCount, dev);
    (void)hipOccupancyMaxActiveBlocksPerMultiprocessor(&per_cu, mega, 512, SHM_TOTAL);
    grid_blocks = cus * per_cu;
    if (grid_blocks > 256 || grid_blocks <= 0) grid_blocks = 256;
  }
  (void)hipMemsetAsync(p.bar, 0, (size_t)XCD_BAR_WORDS * 4, stream);
#if MULTI_LAUNCH
  for (int s = 0; s < NSTEPS; ++s) {
    p.step_lo = s;
    p.step_hi = s + 1;
    hipLaunchKernelGGL(mega, dim3(grid_blocks), dim3(512), SHM_TOTAL, stream, p);
  }
#else
  p.step_lo = 0;
  p.step_hi = NSTEPS;
  void* args[] = {&p};
  (void)hipLaunchCooperativeKernel((void*)mega, dim3(grid_blocks), dim3(512), args, SHM_TOTAL, stream);
#endif
}
```
